# Optimizing an MI355X kernel written in HIP

```python
import math
import jax, jax.numpy as jnp
from jax import lax
import numpy as np

D_MODEL = 1024
BATCH = 4
SEQ = 8192
DEPTH = 2

ROPE_THETA = 10000.0
NORM_EPS = 1e-6
Q_BLOCK = 128

MOBA_HEADS = 8
MOBA_HEAD_DIM = 64
MOBA_BLOCK = 256
MOBA_TOPK = 3
MOBA_Q_CHUNK = 32

DIFF_HEADS = 4
DIFF_HEAD_DIM = 64
DIFF_V_DIM = 2 * DIFF_HEAD_DIM

MOBA_W = MOBA_HEADS * MOBA_HEAD_DIM
DIFF_QK_W = DIFF_HEADS * 2 * DIFF_HEAD_DIM
DIFF_V_W = DIFF_HEADS * DIFF_V_DIM
EVEN_IN = 3 * MOBA_W + 2 * DIFF_QK_W + DIFF_V_W
EVEN_MIX = MOBA_W + DIFF_V_W
EVEN_SPLITS = (MOBA_W, 2 * MOBA_W, 3 * MOBA_W, 3 * MOBA_W + DIFF_QK_W, 3 * MOBA_W + 2 * DIFF_QK_W)

MLA_HEADS = 16
MLA_Q_RANK = 256
MLA_KV_RANK = 128
MLA_NOPE = 64
MLA_ROPE = 32
MLA_V = 64
ODD_IN = MLA_Q_RANK + MLA_KV_RANK + MLA_ROPE
ODD_MIX = MLA_HEADS * MLA_V

N_GROUPS = 4
EXPERTS_PER_GROUP = 8
N_EXPERTS = N_GROUPS * EXPERTS_PER_GROUP
EXPERT_TOPK = 2
EXPERT_FF = 256

N_EVEN = (DEPTH + 1) // 2
N_ODD = DEPTH // 2

kernel_name = "hybrid_moba_diffattn_mla_hiermoe"


def rms_norm(x, g):
    xf = x.astype(jnp.float32)
    y = xf * lax.rsqrt(jnp.mean(xf * xf, axis=-1, keepdims=True) + NORM_EPS)
    return (y * g.astype(jnp.float32)).astype(x.dtype)


def rope_tables(seq, dim):
    inv = 1.0 / (ROPE_THETA ** (jnp.arange(0, dim, 2, dtype=jnp.float32) / dim))
    ang = jnp.arange(seq, dtype=jnp.float32)[:, None] * inv[None, :]
    return jnp.cos(ang), jnp.sin(ang)


def apply_rope(x, cos, sin):
    shp = (1, cos.shape[0]) + (1,) * (x.ndim - 3) + (cos.shape[1],)
    c = cos.reshape(shp).astype(x.dtype)
    s = sin.reshape(shp).astype(x.dtype)
    h = x.shape[-1] // 2
    x1, x2 = x[..., :h], x[..., h:]
    return jnp.concatenate([x1 * c - x2 * s, x1 * s + x2 * c], axis=-1)


def causal_attention(q, k, v, scale):
    B, S, H, dk = q.shape
    nq = S // Q_BLOCK
    qb = q.reshape(B, nq, Q_BLOCK, H, dk).transpose(1, 0, 3, 2, 4)
    kt = k.transpose(0, 2, 1, 3)
    vt = v.transpose(0, 2, 1, 3)
    kpos = jnp.arange(S)

    def step(args):
        q_blk, i = args
        qpos = i * Q_BLOCK + jnp.arange(Q_BLOCK)
        s = jnp.einsum('bhqd,bhkd->bhqk', q_blk, kt).astype(jnp.float32) * scale
        s = jnp.where(kpos[None, :] <= qpos[:, None], s, -jnp.inf)
        p = jax.nn.softmax(s, axis=-1).astype(v.dtype)
        return jnp.einsum('bhqk,bhkd->bqhd', p, vt)

    o = lax.map(step, (qb, jnp.arange(nq)))
    return o.transpose(1, 0, 2, 3, 4).reshape(B, S, H, v.shape[-1])


def diff_attention(q1, q2, k1, k2, v, lam):
    B, S, H, d = q1.shape
    scale = d ** -0.5
    nq = S // Q_BLOCK

    def to_blocks(q):
        return q.reshape(B, nq, Q_BLOCK, H, d).transpose(1, 0, 3, 2, 4)

    k1t = k1.transpose(0, 2, 1, 3)
    k2t = k2.transpose(0, 2, 1, 3)
    vt = v.transpose(0, 2, 1, 3)
    kpos = jnp.arange(S)

    def step(args):
        q1b, q2b, i = args
        qpos = i * Q_BLOCK + jnp.arange(Q_BLOCK)
        causal = kpos[None, :] <= qpos[:, None]
        s1 = jnp.where(causal, jnp.einsum('bhqd,bhkd->bhqk', q1b, k1t).astype(jnp.float32) * scale, -jnp.inf)
        s2 = jnp.where(causal, jnp.einsum('bhqd,bhkd->bhqk', q2b, k2t).astype(jnp.float32) * scale, -jnp.inf)
        a = jax.nn.softmax(s1, axis=-1) - lam * jax.nn.softmax(s2, axis=-1)
        return jnp.einsum('bhqk,bhkd->bqhd', a.astype(v.dtype), vt)

    o = lax.map(step, (to_blocks(q1), to_blocks(q2), jnp.arange(nq)))
    return o.transpose(1, 0, 2, 3, 4).reshape(B, S, H, v.shape[-1])


def moba_attention(q, k, v):
    B, S, H, d = q.shape
    L = MOBA_BLOCK
    nb = -(-S // L)
    pad = nb * L - S
    kp = jnp.pad(k, ((0, 0), (0, pad), (0, 0), (0, 0)))
    vp = jnp.pad(v, ((0, 0), (0, pad), (0, 0), (0, 0)))
    kb = kp.reshape(B, nb, L, H, d).transpose(0, 3, 1, 2, 4)
    vb = vp.reshape(B, nb, L, H, d).transpose(0, 3, 1, 2, 4)
    kmean = jnp.mean(kb.astype(jnp.float32), axis=3).astype(k.dtype)
    topk_n = max(1, min(MOBA_TOPK, nb - 1))
    nc = S // MOBA_Q_CHUNK
    qc = q.reshape(B, nc, MOBA_Q_CHUNK, H, d).transpose(1, 0, 3, 2, 4)
    scale = d ** -0.5
    bidx = jnp.arange(nb)
    b_ar = jnp.arange(B)[:, None, None, None]
    h_ar = jnp.arange(H)[None, :, None, None]

    def step(args):
        q_blk, c = args
        qpos = c * MOBA_Q_CHUNK + jnp.arange(MOBA_Q_CHUNK)
        own = qpos[0] // L
        g = jnp.einsum('bhqd,bhnd->bhqn', q_blk, kmean).astype(jnp.float32)
        past = bidx[None, :] < (qpos // L)[:, None]
        g = jnp.where(past, g, -jnp.inf)
        gv, sel = lax.top_k(g, topk_n)
        valid = jnp.isfinite(gv)
        k_sel = kb[b_ar, h_ar, sel]
        v_sel = vb[b_ar, h_ar, sel]
        s_sel = jnp.einsum('bhqd,bhqnld->bhqnl', q_blk, k_sel).astype(jnp.float32) * scale
        s_sel = jnp.where(valid[..., None], s_sel, -jnp.inf).reshape(B, H, MOBA_Q_CHUNK, topk_n * L)
        k_own = lax.dynamic_index_in_dim(kb, own, axis=2, keepdims=False)
        v_own = lax.dynamic_index_in_dim(vb, own, axis=2, keepdims=False)
        s_own = jnp.einsum('bhqd,bhld->bhql', q_blk, k_own).astype(jnp.float32) * scale
        own_pos = own * L + jnp.arange(L)
        s_own = jnp.where(own_pos[None, :] <= qpos[:, None], s_own, -jnp.inf)
        p = jax.nn.softmax(jnp.concatenate([s_sel, s_own], axis=-1), axis=-1).astype(v.dtype)
        p_sel = p[..., :topk_n * L].reshape(B, H, MOBA_Q_CHUNK, topk_n, L)
        p_own = p[..., topk_n * L:]
        return (jnp.einsum('bhqnl,bhqnld->bqhd', p_sel, v_sel)
                + jnp.einsum('bhql,bhld->bqhd', p_own, v_own))

    o = lax.map(step, (qc, jnp.arange(nc)))
    return o.transpose(1, 0, 2, 3, 4).reshape(B, S, H, d)


def even_mixer(h, w_in, lq1, lk1, lq2, lk2, subln_g, w_out, lam_init, cos, sin):
    B, S, _ = h.shape
    z = h @ w_in
    mq, mk, mv, dq, dk, dv = jnp.split(z, EVEN_SPLITS, axis=-1)
    mq = apply_rope(mq.reshape(B, S, MOBA_HEADS, MOBA_HEAD_DIM), cos, sin)
    mk = apply_rope(mk.reshape(B, S, MOBA_HEADS, MOBA_HEAD_DIM), cos, sin)
    mv = mv.reshape(B, S, MOBA_HEADS, MOBA_HEAD_DIM)
    o_a = moba_attention(mq, mk, mv).reshape(B, S, MOBA_W)

    dq = apply_rope(dq.reshape(B, S, DIFF_HEADS, 2, DIFF_HEAD_DIM), cos, sin)
    dk = apply_rope(dk.reshape(B, S, DIFF_HEADS, 2, DIFF_HEAD_DIM), cos, sin)
    dv = dv.reshape(B, S, DIFF_HEADS, DIFF_V_DIM)
    f32 = jnp.float32
    lam = (jnp.exp(jnp.sum(lq1.astype(f32) * lk1.astype(f32)))
           - jnp.exp(jnp.sum(lq2.astype(f32) * lk2.astype(f32))) + lam_init)
    o_b = diff_attention(dq[..., 0, :], dq[..., 1, :], dk[..., 0, :], dk[..., 1, :], dv, lam)
    o_b = (rms_norm(o_b, subln_g) * (1.0 - lam_init)).reshape(B, S, DIFF_V_W)
    return jnp.concatenate([o_a, o_b], axis=-1) @ w_out


def mla_mixer(h, w_in, q_norm_g, kv_norm_g, w_q_up, w_kv_up, w_out, cos, sin):
    B, S, _ = h.shape
    z = h @ w_in
    cq, ckv, kr = jnp.split(z, (MLA_Q_RANK, MLA_Q_RANK + MLA_KV_RANK), axis=-1)
    q = (rms_norm(cq, q_norm_g) @ w_q_up).reshape(B, S, MLA_HEADS, MLA_NOPE + MLA_ROPE)
    q = jnp.concatenate([q[..., :MLA_NOPE], apply_rope(q[..., MLA_NOPE:], cos, sin)], axis=-1)
    kv = (rms_norm(ckv, kv_norm_g) @ w_kv_up).reshape(B, S, MLA_HEADS, MLA_NOPE + MLA_V)
    k_rope = apply_rope(kr[:, :, None, :], cos, sin)
    k = jnp.concatenate([kv[..., :MLA_NOPE],
                         jnp.broadcast_to(k_rope, (B, S, MLA_HEADS, MLA_ROPE))], axis=-1)
    v = kv[..., MLA_NOPE:]
    o = causal_attention(q, k, v, (MLA_NOPE + MLA_ROPE) ** -0.5)
    return o.reshape(B, S, ODD_MIX) @ w_out


def hier_moe(h, w_group, b_group, w_expert, b_expert, w_gate, w_up, w_down):
    B, S, D = h.shape
    t = h.reshape(-1, D)
    N = t.shape[0]
    gp = jax.nn.softmax((t @ w_group).astype(jnp.float32) + b_group.astype(jnp.float32), axis=-1)
    grp = jnp.argmax(gp, axis=-1)
    pg = jnp.take_along_axis(gp, grp[:, None], axis=1)[:, 0]
    el = ((t @ w_expert).astype(jnp.float32) + b_expert.astype(jnp.float32)).reshape(N, N_GROUPS, EXPERTS_PER_GROUP)
    el_g = jnp.take_along_axis(el, grp[:, None, None], axis=1)[:, 0]
    pv, pi = lax.top_k(jax.nn.softmax(el_g, axis=-1), EXPERT_TOPK)
    w = pg[:, None] * pv / jnp.sum(pv, axis=-1, keepdims=True)
    eid = grp[:, None] * EXPERTS_PER_GROUP + pi
    gates = jnp.zeros((N, N_EXPERTS), jnp.float32).at[jnp.arange(N)[:, None], eid].add(w)

    def expert_step(acc, params):
        wg, wu, wd, ge = params
        hh = jax.nn.silu(t @ wg) * (t @ wu)
        return acc + ge[:, None].astype(t.dtype) * (hh @ wd), None

    out, _ = lax.scan(expert_step, jnp.zeros_like(t), (w_gate, w_up, w_down, gates.T))
    return out.reshape(B, S, D)


def setup_inputs(seed: int = 0) -> dict:
    key = jax.random.key(seed)
    ks = jax.random.split(key, 32)
    D = D_MODEL

    def nrm(k, shape, scale):
        return jax.random.normal(k, shape, jnp.float32) * scale

    return {
        "x": nrm(ks[0], (BATCH, SEQ, D), 1.0),
        "attn_norm": 1.0 + nrm(ks[1], (DEPTH, D), 0.02),
        "ev_w_in": nrm(ks[2], (N_EVEN, D, EVEN_IN), D ** -0.5),
        "ev_lambda_q1": nrm(ks[3], (N_EVEN, DIFF_HEAD_DIM), 0.1),
        "ev_lambda_k1": nrm(ks[4], (N_EVEN, DIFF_HEAD_DIM), 0.1),
        "ev_lambda_q2": nrm(ks[5], (N_EVEN, DIFF_HEAD_DIM), 0.1),
        "ev_lambda_k2": nrm(ks[6], (N_EVEN, DIFF_HEAD_DIM), 0.1),
        "ev_subln": 1.0 + nrm(ks[7], (N_EVEN, DIFF_V_DIM), 0.02),
        "ev_w_out": nrm(ks[8], (N_EVEN, EVEN_MIX, D), EVEN_MIX ** -0.5),
        "od_w_in": nrm(ks[9], (N_ODD, D, ODD_IN), D ** -0.5),
        "od_q_norm": 1.0 + nrm(ks[10], (N_ODD, MLA_Q_RANK), 0.02),
        "od_kv_norm": 1.0 + nrm(ks[11], (N_ODD, MLA_KV_RANK), 0.02),
        "od_w_q_up": nrm(ks[12], (N_ODD, MLA_Q_RANK, MLA_HEADS * (MLA_NOPE + MLA_ROPE)), MLA_Q_RANK ** -0.5),
        "od_w_kv_up": nrm(ks[13], (N_ODD, MLA_KV_RANK, MLA_HEADS * (MLA_NOPE + MLA_V)), MLA_KV_RANK ** -0.5),
        "od_w_out": nrm(ks[14], (N_ODD, ODD_MIX, D), ODD_MIX ** -0.5),
        "ffn_norm": 1.0 + nrm(ks[15], (DEPTH, D), 0.02),
        "moe_w_group": nrm(ks[16], (DEPTH, D, N_GROUPS), D ** -0.5),
        "moe_b_group": nrm(ks[17], (DEPTH, N_GROUPS), 0.01),
        "moe_w_expert": nrm(ks[18], (DEPTH, D, N_EXPERTS), D ** -0.5),
        "moe_b_expert": nrm(ks[19], (DEPTH, N_EXPERTS), 0.01),
        "moe_w_gate": nrm(ks[20], (DEPTH, N_EXPERTS, D, EXPERT_FF), D ** -0.5),
        "moe_w_up": nrm(ks[21], (DEPTH, N_EXPERTS, D, EXPERT_FF), D ** -0.5),
        "moe_w_down": nrm(ks[22], (DEPTH, N_EXPERTS, EXPERT_FF, D), EXPERT_FF ** -0.5),
        "final_norm": 1.0 + nrm(ks[23], (D,), 0.02),
    }


def reference(x, attn_norm, ev_w_in, ev_lambda_q1, ev_lambda_k1, ev_lambda_q2, ev_lambda_k2,
              ev_subln, ev_w_out, od_w_in, od_q_norm, od_kv_norm, od_w_q_up, od_w_kv_up, od_w_out,
              ffn_norm, moe_w_group, moe_b_group, moe_w_expert, moe_b_expert, moe_w_gate,
              moe_w_up, moe_w_down, final_norm):
    S = x.shape[1]
    cos_h, sin_h = rope_tables(S, MOBA_HEAD_DIM)
    cos_r, sin_r = rope_tables(S, MLA_ROPE)
    for layer in range(DEPTH):
        j = layer // 2
        h = rms_norm(x, attn_norm[layer])
        if layer % 2 == 0:
            lam_init = 0.8 - 0.6 * math.exp(-0.3 * layer)
            x = x + even_mixer(h, ev_w_in[j], ev_lambda_q1[j], ev_lambda_k1[j], ev_lambda_q2[j],
                               ev_lambda_k2[j], ev_subln[j], ev_w_out[j], lam_init, cos_h, sin_h)
        else:
            x = x + mla_mixer(h, od_w_in[j], od_q_norm[j], od_kv_norm[j], od_w_q_up[j],
                              od_w_kv_up[j], od_w_out[j], cos_r, sin_r)
        x = x + hier_moe(rms_norm(x, ffn_norm[layer]), moe_w_group[layer], moe_b_group[layer],
                         moe_w_expert[layer], moe_b_expert[layer], moe_w_gate[layer],
                         moe_w_up[layer], moe_w_down[layer])
    return rms_norm(x, final_norm)
```

```cpp
#include <hip/hip_runtime.h>
#include <cstdio>
#include <cstdint>
#include <cmath>

constexpr int NT = 32768, DM = 1024, SEQ = 8192, NBATCH = 4;
constexpr int EVEN_IN = 3072, ODD_IN = 416, ODD_INP = 512;
constexpr int NEXP = 32, FF = 256;
constexpr float NORM_EPS = 1e-6f;
constexpr float LOG2E = 1.4426950408889634f;
constexpr float C2_64 = 0.125f * LOG2E;
constexpr float C2_96 = 0.10206207261596575f * LOG2E;
constexpr float LAM_INIT = 0.2f;

typedef unsigned short bf16_t;
typedef float f32x4 __attribute__((ext_vector_type(4)));
typedef float f32x2 __attribute__((ext_vector_type(2)));
typedef unsigned u32x4 __attribute__((ext_vector_type(4)));
typedef unsigned u32x2 __attribute__((ext_vector_type(2)));
typedef int i32x4 __attribute__((ext_vector_type(4)));

constexpr size_t MiB = 1u << 20;
constexpr size_t WS_CTL = 0, CTL_BYTES = 1 * MiB;
constexpr size_t CTL_CNT0 = 4096, CTL_CNT1 = 4096 + 256;
constexpr size_t CTL_Q2 = 8192, CTL_Q10 = 8192 + 2048;
constexpr size_t CTL_KMEAN = 512 * 1024;
constexpr size_t WS_W_IN0T = 1 * MiB;
constexpr size_t WS_W_OUT0T = WS_W_IN0T + 6 * MiB;
constexpr size_t WS_W_IN1T = WS_W_OUT0T + 2 * MiB;
constexpr size_t WS_W_QUPT = WS_W_IN1T + 1 * MiB;
constexpr size_t WS_W_KVUPT = WS_W_QUPT + 1 * MiB;
constexpr size_t WS_W_OUT1T = WS_W_KVUPT + 1 * MiB;
constexpr size_t WS_W_UPT = WS_W_OUT1T + 2 * MiB;
constexpr size_t WS_W_DNT = WS_W_UPT + 64 * MiB;
constexpr size_t WS_W_RT = WS_W_DNT + 32 * MiB;
constexpr size_t WS_CS64 = WS_W_RT + 1 * MiB;
constexpr size_t WS_CS32 = WS_CS64 + 2 * MiB;
constexpr size_t WS_RSTD = WS_CS32 + 1 * MiB;
constexpr size_t WS_GW = WS_RSTD + 512 * 1024;
constexpr size_t WS_LIST = WS_GW + 512 * 1024;
constexpr size_t WS_XB = WS_LIST + 4 * MiB;
constexpr size_t WS_OMIX = WS_XB + 64 * MiB;
constexpr size_t WS_BIG = WS_OMIX + 64 * MiB;
constexpr size_t WS_QKV0 = WS_BIG;
constexpr size_t WS_Y = WS_BIG;
constexpr size_t WS_H = WS_BIG + 128 * MiB;
constexpr size_t WS_Q1 = WS_BIG;
constexpr size_t WS_KN1 = WS_BIG + 96 * MiB;
constexpr size_t WS_V1 = WS_BIG + 160 * MiB;
constexpr size_t WS_Z1 = WS_BIG + 224 * MiB;
constexpr size_t WS_KR = WS_BIG + 256 * MiB;
constexpr size_t WS_END = WS_BIG + 258 * MiB;
static_assert(WS_END <= 512 * MiB, "workspace map exceeds 512 MiB");
constexpr size_t WS_PO0 = WS_XB, WS_PO1 = WS_XB + 32 * MiB, WS_PO2 = WS_BIG + 192 * MiB;
constexpr size_t WS_PML = WS_BIG + 224 * MiB;
constexpr size_t WS_LST = WS_BIG + 232 * MiB;
__host__ __device__ __forceinline__ size_t lst_base(int l) { const int bh = l >> 5, j = l & 31; return (size_t)bh * 126976 + (size_t)256 * (31 * j - (j * (j - 1)) / 2); }
constexpr size_t CTL_LCNT = 32768, CTL_Q2B = 36864;
constexpr size_t WS_SCR = WS_BIG + 192 * MiB;

__host__ __device__ __forceinline__ unsigned f2bf(float f) { unsigned u = __builtin_bit_cast(unsigned, f); return (u + 0x7fffu + ((u >> 16) & 1u)) >> 16; }
__host__ __device__ __forceinline__ float bf2f(unsigned short h) { return __builtin_bit_cast(float, (unsigned)h << 16); }
__device__ __forceinline__ float wave_sum(float v) {
#pragma unroll
    for (int o = 1; o < 64; o <<= 1) v += __shfl_xor(v, o);
    return v;
}
__host__ __device__ __forceinline__ int perm8(int p) { return (p & ~31) | (((p >> 2) & 3) << 3) | (((p >> 4) & 1) << 2) | (p & 3); }
__host__ __device__ __forceinline__ int win0_truecol(int p) {
    { const int un = p >> 8; if (un == 4 || un == 5 || un >= 10) return perm8(p); }
    const int u = p >> 8, q = p & 255, bj = q >> 7, wc = (q >> 5) & 3, n = (q >> 4) & 1, lo = q & 15;
    return (u << 8) + 64 * (2 * bj + (wc >> 1)) + 32 * n + 16 * (wc & 1) + lo;
}
__host__ __device__ __forceinline__ int qup_truecol(int p) {
    if (p < 1024) { const int c = perm8(p); return (c >> 6) * 96 + (c & 63); }
    const int q = p - 1024; return (q >> 5) * 96 + 64 + (q & 31);
}

__device__ __forceinline__ void sincos_d(double x, double& s, double& c) {
    const double k = rint(x * 0.63661977236758134308);
    double r = fma(-k, 1.57079632679489655800e+00, x); r = fma(-k, 6.12323399573676603587e-17, r);
    const double r2 = r * r;
    double sp = r2 * (-1.0 / 6227020800.0) + (1.0 / 39916800.0); sp = sp * r2 - (1.0 / 362880.0); sp = sp * r2 + (1.0 / 5040.0); sp = sp * r2 - (1.0 / 120.0); sp = sp * r2 + (1.0 / 6.0);
    const double sr = r - r * r2 * sp;
    double cp = r2 * (1.0 / 479001600.0) - (1.0 / 3628800.0); cp = cp * r2 + (1.0 / 40320.0); cp = cp * r2 - (1.0 / 720.0); cp = cp * r2 + (1.0 / 24.0); cp = cp * r2 - 0.5;
    const double cr = 1.0 + r2 * cp;
    const long long ki = (long long)k; const int q = (int)(ki & 3);
    s = (q == 0) ? sr : (q == 1) ? cr : (q == 2) ? -sr : -cr;
    c = (q == 0) ? cr : (q == 1) ? -sr : (q == 2) ? -cr : sr;
}

#define LAS __attribute__((address_space(3)))
#define GAS __attribute__((address_space(1)))
typedef short bf16x8 __attribute__((ext_vector_type(8)));
typedef float f32x16 __attribute__((ext_vector_type(16)));
constexpr int NWAVES = 8, NTHREADS = 512;
constexpr int LDS_RING = 131072;
constexpr int LDS_MISC = LDS_RING;
constexpr int LM_BAR = 0;
constexpr int LM_CNT = 256;
constexpr int LM_PBASE = 512;
constexpr int LM_STAT = 1024;
constexpr int LM_ROWOFF = 5120;
constexpr int LM_ATTN = 13312;
constexpr int LM_QSLOT = 128;
constexpr int LM_LCNT = 768;
constexpr int LDS_BYTES = 147456;

extern __shared__ __attribute__((aligned(16))) unsigned char lds_raw[];
constexpr int LM_WTAB = 15360;
__device__ __forceinline__ int hw_wave_slot() { return (int)(__builtin_amdgcn_s_getreg((5 << 11) | 4) & 63u); }
__device__ __forceinline__ int my_tid() {
    const int wid = __builtin_amdgcn_readfirstlane(((LAS const volatile int*)((LAS unsigned char*)lds_raw + LDS_MISC + LM_WTAB))[hw_wave_slot()]);
    return wid * 64 + (int)__builtin_amdgcn_mbcnt_hi(~0u, __builtin_amdgcn_mbcnt_lo(~0u, 0u));
}

__device__ __forceinline__ unsigned cvt_pk_bf16(float lo, float hi) { typedef __bf16 bf16x2_t __attribute__((ext_vector_type(2))); f32x2 v = {lo, hi}; bf16x2_t b = __builtin_convertvector(v, bf16x2_t); return __builtin_bit_cast(unsigned, b); }

namespace pg8 {
constexpr int BM = 256, BK = 64, HALF = 128, HTB = HALF * BK * 2, STAGE_BYTES = 8 * HTB, NXCD = 8, WGM = 8;
__host__ __device__ __forceinline__ int lds_byte(int r, int c) { const int st = (r >> 4) * 2 + (c >> 5), rr = r & 15, cc = c & 31, ob = rr * 64 + cc * 2; return st * 1024 + (ob ^ (((ob >> 9) & 1) << 5)); }
__host__ __device__ __forceinline__ void stage_rc(int b, int& R, int& C) { const int st = b / 1024, sb = b % 1024, swz = sb ^ (((sb >> 9) & 1) << 5); R = (st >> 1) * 16 + swz / 64; C = (st & 1) * 32 + (swz % 64) / 2; }

struct Unit { int pm, pn, e, panel, nrows, slot; };

struct DenseSched {
    const char* A; const char* Bt; unsigned lda_b; unsigned K2;
    int nM, nN, nwg, G, c;
    __device__ void init(const void* A_, unsigned lda_bytes, const void* Bt_, int M, int N, int K, int G_, int c_) { A = (const char*)A_; Bt = (const char*)Bt_; lda_b = lda_bytes; K2 = (unsigned)K * 2u; nM = M / BM; nN = N / BM; nwg = nM * nN; G = G_; c = c_; }
    __device__ __forceinline__ bool next(int i, Unit& u) const {
        const long L = (long)i * G + c; if (L >= nwg) return false;
        int wgid = (int)L; { const int q = nwg / NXCD, r = nwg % NXCD, xcd = wgid % NXCD, off = wgid / NXCD; wgid = (xcd < r ? xcd * (q + 1) : r * (q + 1) + (xcd - r) * q) + off; }
        const int nig = WGM * nN, gid = wgid / nig, fm = gid * WGM, gsz = (nM - fm) < WGM ? (nM - fm) : WGM;
        u.pm = fm + ((wgid % nig) % gsz); u.pn = (wgid % nig) / gsz; u.e = 0; u.panel = 0; u.nrows = 256; u.slot = 0; return true;
    }
    static constexpr bool GATHER = false;
    __device__ __forceinline__ const char* abase(const Unit& u) const { return A + (size_t)u.pm * BM * lda_b; }
    __device__ __forceinline__ unsigned lda() const { return lda_b; }
    __device__ __forceinline__ unsigned arow(const Unit&, int) const { return 0u; }
    __device__ __forceinline__ const char* bbase(const Unit& u) const { return Bt + (size_t)u.pn * BM * K2; }
};

template <class Epi, class Sched, bool ALIGN_EPI, bool SP2>
__device__ __forceinline__ void gemm_phase(LAS unsigned char* lds, const int K, const Sched& S, const Epi& E) {
    int tid_ = my_tid(); asm volatile("" : "+v"(tid_));
    const int tid = tid_, wid = __builtin_amdgcn_readfirstlane(tid >> 6), lane = tid & 63, wr = wid >> 2, wc = wid & 3, fr = lane & 15, fq = lane >> 4;
    int nt = K / BK; asm volatile("" : "+s"(nt));
    int sR[2], sC[2]; unsigned voffB[2], voffA[2];
#pragma unroll
    for (int i = 0; i < 2; ++i) { stage_rc(tid * 16 + i * 8192, sR[i], sC[i]); voffB[i] = (unsigned)(sR[i] * K + sC[i]) * 2u; voffA[i] = Sched::GATHER ? (unsigned)sC[i] * 2u : (unsigned)sR[i] * S.lda() + (unsigned)sC[i] * 2u; }
    const size_t kstep = (size_t)(BK * 2);
    const size_t hstepB = (size_t)HALF * K * 2;
    const size_t hstepA = Sched::GATHER ? 0 : (size_t)HALF * S.lda();
    const unsigned ldsw = (unsigned)wid * 1024u;
    const int aoff = lds_byte(wr * 64 + fr, fq * 8), boff = lds_byte(wc * 32 + fr, fq * 8);
#define PG8_SA(b, h) (((b) * 2 + (h)) * HTB)
#define PG8_SB(b, h) ((4 + (b) * 2 + (h)) * HTB)
#define PG8_STAGE(bufoff, gbase, voff) do { _Pragma("unroll") for (int _i = 0; _i < 2; ++_i) \
        __builtin_amdgcn_global_load_lds((const GAS unsigned*)((const char*)(gbase) + (voff)[_i]), (LAS unsigned*)(lds + (bufoff) + ldsw + _i * 8192), 16, 0, 0); } while (0)
#define PG8_STAGE_A(bufoff, gbase, h, VV) do { if constexpr (Sched::GATHER) { PG8_STAGE(bufoff, gbase, (VV)[h]); } else { PG8_STAGE(bufoff, (gbase) + (h) * hstepA, voffA); } } while (0)
#define PG8_LDA(dst, b, h) do { _Pragma("unroll") for (int m = 0; m < 4; ++m) _Pragma("unroll") for (int k = 0; k < 2; ++k) dst[m][k] = *(const LAS bf16x8*)(lds + PG8_SA(b, h) + aoff + m * 2048 + k * 1024); } while (0)
#define PG8_LDB(dst, b, h) do { _Pragma("unroll") for (int n = 0; n < 2; ++n) _Pragma("unroll") for (int k = 0; k < 2; ++k) dst[n][k] = *(const LAS bf16x8*)(lds + PG8_SB(b, h) + boff + n * 2048 + k * 1024); } while (0)
#define PG8_MMA(ai, bj, At, Bt) do { __builtin_amdgcn_s_setprio(1); _Pragma("unroll") for (int m = 0; m < 4; ++m) _Pragma("unroll") for (int n = 0; n < 2; ++n) _Pragma("unroll") for (int k = 0; k < 2; ++k) \
        acc[ai][bj][m][n] = __builtin_amdgcn_mfma_f32_16x16x32_bf16(Bt[n][k], At[m][k], acc[ai][bj][m][n], 0, 0, 0); __builtin_amdgcn_s_setprio(0); } while (0)
#define PG8_WAIT_V(n) asm volatile("s_waitcnt vmcnt(" #n ")" ::: "memory")
#define PG8_WAIT_L(n) asm volatile("s_waitcnt lgkmcnt(" #n ")" ::: "memory")
#define PG8_BAR __builtin_amdgcn_s_barrier()
#define PG8_SCHED __builtin_amdgcn_sched_barrier(0)
#define PG8_VOFF(dst, u) do { if constexpr (Sched::GATHER) { _Pragma("unroll") for (int _h = 0; _h < 2; ++_h) _Pragma("unroll") for (int _i = 0; _i < 2; ++_i) dst[_h][_i] = S.arow(u, _h * HALF + sR[_i]) + voffA[_i]; } } while (0)
    Unit cur, nxt; int ui = 0;
    if (!S.next(0, cur)) return;
    f32x4 acc[2][2][4][2];
#pragma unroll
    for (int a = 0; a < 2; ++a)
#pragma unroll
        for (int b = 0; b < 2; ++b)
#pragma unroll
            for (int m = 0; m < 4; ++m)
#pragma unroll
                for (int n = 0; n < 2; ++n) acc[a][b][m][n] = (f32x4){0.f, 0.f, 0.f, 0.f};
    bf16x8 At[4][2], B0[2][2], B1[2][2];
    unsigned cv[2][2] = {{0u, 0u}, {0u, 0u}};
    PG8_VOFF(cv, cur);
    const char* cA = S.abase(cur); const char* cB = S.bbase(cur);
    if constexpr (SP2) {
        PG8_STAGE(PG8_SB(0, 0), cB, voffB); PG8_STAGE(PG8_SB(0, 1), cB + hstepB, voffB); PG8_STAGE_A(PG8_SA(0, 0), cA, 0, cv); PG8_STAGE_A(PG8_SA(0, 1), cA, 1, cv);
        if (wr == 1) PG8_BAR;
        PG8_WAIT_V(2); PG8_BAR;
        PG8_STAGE(PG8_SB(1, 0), cB + kstep, voffB); PG8_STAGE_A(PG8_SA(1, 0), cA + kstep, 0, cv); PG8_STAGE(PG8_SB(1, 1), cB + hstepB + kstep, voffB);
        PG8_WAIT_V(6); PG8_BAR;
    } else {
        PG8_STAGE(PG8_SB(0, 0), cB, voffB); PG8_STAGE_A(PG8_SA(0, 0), cA, 0, cv); PG8_STAGE(PG8_SB(0, 1), cB + hstepB, voffB); PG8_STAGE_A(PG8_SA(0, 1), cA, 1, cv);
        if (wr == 1) PG8_BAR;
        PG8_WAIT_V(4); PG8_BAR;
        PG8_STAGE(PG8_SB(1, 0), cB + kstep, voffB); PG8_STAGE_A(PG8_SA(1, 0), cA + kstep, 0, cv); PG8_STAGE(PG8_SB(1, 1), cB + hstepB + kstep, voffB);
        PG8_WAIT_V(6); PG8_BAR;
    }
    for (;;) {
        const bool has_next = S.next(ui + 1, nxt);
        const char* nA = has_next ? S.abase(nxt) : cA; const char* nB = has_next ? S.bbase(nxt) : cB;
        for (int t = 0; t < nt; t += 2) {
            const bool last = (t == nt - 2);
            const char* a1 = cA + (size_t)(t + 1) * kstep;
            const char* a2 = last ? nA : cA + (size_t)(t + 2) * kstep; const char* b2 = last ? nB : cB + (size_t)(t + 2) * kstep;
            const char* a3 = a2 + kstep; const char* b3 = b2 + kstep;
            if constexpr (SP2) {
            PG8_LDB(B0, 0, 0); PG8_LDB(B1, 0, 1); PG8_SCHED; PG8_LDA(At, 0, 0); PG8_STAGE_A(PG8_SA(1, 1), a1, 1, cv);
            if (last && has_next) { PG8_VOFF(cv, nxt); }
            PG8_WAIT_V(8); PG8_WAIT_L(0); PG8_BAR; PG8_MMA(0, 0, At, B0); PG8_MMA(0, 1, At, B1); PG8_BAR; PG8_SCHED;
            PG8_LDA(At, 0, 1); PG8_STAGE(PG8_SB(0, 0), b2, voffB); PG8_STAGE(PG8_SB(0, 1), b2 + hstepB, voffB); PG8_STAGE_A(PG8_SA(0, 0), a2, 0, cv);
            PG8_WAIT_V(8); PG8_WAIT_L(0); PG8_BAR; PG8_MMA(1, 0, At, B0); PG8_MMA(1, 1, At, B1); PG8_BAR; PG8_SCHED;
            PG8_LDB(B0, 1, 0); PG8_LDB(B1, 1, 1); PG8_SCHED; PG8_LDA(At, 1, 0); PG8_STAGE_A(PG8_SA(0, 1), a2, 1, cv);
            PG8_WAIT_V(8); PG8_WAIT_L(0); PG8_BAR; PG8_MMA(0, 0, At, B0); PG8_MMA(0, 1, At, B1); PG8_BAR; PG8_SCHED;
            PG8_LDA(At, 1, 1); PG8_STAGE(PG8_SB(1, 0), b3, voffB); PG8_STAGE(PG8_SB(1, 1), b3 + hstepB, voffB); PG8_STAGE_A(PG8_SA(1, 0), a3, 0, cv);
            PG8_WAIT_V(8); PG8_WAIT_L(0); PG8_BAR; PG8_MMA(1, 0, At, B0); PG8_MMA(1, 1, At, B1); PG8_BAR; PG8_SCHED;
            } else {
            PG8_LDB(B0, 0, 0); PG8_SCHED; PG8_LDA(At, 0, 0); PG8_STAGE_A(PG8_SA(1, 1), a1, 1, cv);
            if (last && has_next) { PG8_VOFF(cv, nxt); }
            PG8_WAIT_L(8); PG8_BAR; PG8_WAIT_L(0); PG8_MMA(0, 0, At, B0); PG8_BAR; PG8_SCHED;
            PG8_LDB(B1, 0, 1); PG8_STAGE(PG8_SB(0, 0), b2, voffB);
            PG8_BAR; PG8_WAIT_L(0); PG8_MMA(0, 1, At, B1); PG8_BAR;
            PG8_LDA(At, 0, 1); PG8_STAGE_A(PG8_SA(0, 0), a2, 0, cv);
            PG8_BAR; PG8_WAIT_L(0); PG8_MMA(1, 0, At, B0); PG8_BAR; PG8_SCHED;
            PG8_STAGE(PG8_SB(0, 1), b2 + hstepB, voffB);
            PG8_WAIT_V(6); PG8_BAR; PG8_MMA(1, 1, At, B1); PG8_BAR;
            PG8_LDB(B0, 1, 0); PG8_SCHED; PG8_LDA(At, 1, 0); PG8_STAGE_A(PG8_SA(0, 1), a2, 1, cv);
            PG8_WAIT_L(8); PG8_BAR; PG8_WAIT_L(0); PG8_MMA(0, 0, At, B0); PG8_BAR; PG8_SCHED;
            PG8_LDB(B1, 1, 1); PG8_STAGE(PG8_SB(1, 0), b3, voffB);
            PG8_BAR; PG8_WAIT_L(0); PG8_MMA(0, 1, At, B1); PG8_BAR;
            PG8_LDA(At, 1, 1); PG8_STAGE_A(PG8_SA(1, 0), a3, 0, cv);
            PG8_BAR; PG8_WAIT_L(0); PG8_MMA(1, 0, At, B0); PG8_BAR; PG8_SCHED;
            PG8_STAGE(PG8_SB(1, 1), b3 + hstepB, voffB);
            PG8_WAIT_V(6); PG8_BAR; PG8_MMA(1, 1, At, B1); PG8_BAR;
            }
        }
        if constexpr (ALIGN_EPI) { if (wr == 0) PG8_BAR; }
        E(acc, cur, wr, wc, fr, fq);
        if (!has_next) break;
#pragma unroll
        for (int a = 0; a < 2; ++a)
#pragma unroll
            for (int b = 0; b < 2; ++b)
#pragma unroll
                for (int m = 0; m < 4; ++m)
#pragma unroll
                    for (int n = 0; n < 2; ++n) acc[a][b][m][n] = (f32x4){0.f, 0.f, 0.f, 0.f};
        cur = nxt; cA = nA; cB = nB; ++ui;
        if constexpr (ALIGN_EPI) { if (wr == 1) PG8_BAR; }
    }
    PG8_WAIT_V(0);
    if constexpr (!ALIGN_EPI) { if (wr == 0) PG8_BAR; }
    PG8_BAR;
#undef PG8_SA
#undef PG8_SB
#undef PG8_STAGE
#undef PG8_STAGE_A
#undef PG8_LDA
#undef PG8_LDB
#undef PG8_MMA
#undef PG8_WAIT_V
#undef PG8_WAIT_L
#undef PG8_BAR
#undef PG8_SCHED
#undef PG8_VOFF
}

typedef const f32x4 (&AccRef)[2][2][4][2];

struct EpiWin0 {
    const float* rstd; const f32x2* cs64; bf16_t* qkv; float* kmean;
    __device__ __forceinline__ void operator()(AccRef acc, const Unit& u, int wr, int wc, int fr, int fq) const {
        const int pn = u.pn; const bool rope = (pn < 4) || (pn >= 6 && pn < 10); const bool qs = (pn < 2) || (pn == 6) || (pn == 7); const bool km = (pn == 2) || (pn == 3); const bool vsec = (pn == 4) || (pn == 5) || (pn >= 10);
        const int dlo = 16 * (wc & 1) + 4 * fq;
        f32x4 ks[2][2];
#pragma unroll
        for (int bj = 0; bj < 2; ++bj) { ks[bj][0] = (f32x4){0.f, 0.f, 0.f, 0.f}; ks[bj][1] = (f32x4){0.f, 0.f, 0.f, 0.f}; }
#pragma unroll
        for (int ai = 0; ai < 2; ++ai)
#pragma unroll
            for (int m = 0; m < 4; ++m) {
                const int r = u.pm * BM + ai * HALF + wr * 64 + m * 16 + fr, t = r & (SEQ - 1);
                const float rs = rstd[r];
                f32x4 c4 = {1.f, 1.f, 1.f, 1.f}, s4 = {0.f, 0.f, 0.f, 0.f};
                if (rope) { const f32x4 a = *(const f32x4*)(cs64 + t * 32 + dlo), b = *(const f32x4*)(cs64 + t * 32 + dlo + 2); c4 = (f32x4){a.x, a.z, b.x, b.z}; s4 = (f32x4){a.y, a.w, b.y, b.w}; }
                const float sc = qs ? rs * C2_64 : rs;
#pragma unroll
                for (int bj = 0; bj < 2; ++bj) {
                    const f32x4 x1 = acc[ai][bj][m][0] * sc, x2 = acc[ai][bj][m][1] * sc;
                    const f32x4 y1 = x1 * c4 - x2 * s4, y2 = x1 * s4 + x2 * c4;
                    if (km) { ks[bj][0] += y1; ks[bj][1] += y2; }
                    u32x2 w1, w2; w1.x = cvt_pk_bf16(y1.x, y1.y); w1.y = cvt_pk_bf16(y1.z, y1.w); w2.x = cvt_pk_bf16(y2.x, y2.y); w2.y = cvt_pk_bf16(y2.z, y2.w);
                    if (vsec) { *(u32x4*)(qkv + (size_t)r * EVEN_IN + pn * BM + bj * HALF + wc * 32 + 8 * fq) = (u32x4){w1.x, w1.y, w2.x, w2.y}; }
                    else { bf16_t* dst = qkv + (size_t)r * EVEN_IN + pn * BM + 64 * (2 * bj + (wc >> 1)) + dlo; *(u32x2*)dst = w1; *(u32x2*)(dst + 32) = w2; }
                }
            }
        if (km) {
            const int b = u.pm >> 5, blk = u.pm & 31;
#pragma unroll
            for (int bj = 0; bj < 2; ++bj)
#pragma unroll
                for (int n = 0; n < 2; ++n) { f32x4 v = ks[bj][n];
#pragma unroll
                    for (int o = 1; o < 16; o <<= 1) { v.x += __shfl_xor(v.x, o); v.y += __shfl_xor(v.y, o); v.z += __shfl_xor(v.z, o); v.w += __shfl_xor(v.w, o); }
                    if (fr == 0) { const int h = (pn - 2) * 4 + 2 * bj + (wc >> 1); float* dst = kmean + ((size_t)(b * 8 + h) * 32 + blk) * 64 + 32 * n + dlo;
                        atomicAdd(dst + 0, v.x * (1.0f / 256.0f)); atomicAdd(dst + 1, v.y * (1.0f / 256.0f)); atomicAdd(dst + 2, v.z * (1.0f / 256.0f)); atomicAdd(dst + 3, v.w * (1.0f / 256.0f)); } }
        }
    }
};
template <bool BF> struct EpiWout {
    const float* base_f; bf16_t* xb;
    __device__ __forceinline__ void operator()(AccRef acc, const Unit& u, int wr, int wc, int fr, int fq) const {
#pragma unroll
        for (int ai = 0; ai < 2; ++ai)
#pragma unroll
            for (int m = 0; m < 4; ++m) {
                const size_t off = (size_t)(u.pm * BM + ai * HALF + wr * 64 + m * 16 + fr) * DM + u.pn * BM + wc * 32 + 8 * fq;
#pragma unroll
                for (int bj = 0; bj < 2; ++bj) { const size_t o = off + bj * HALF; f32x4 v0, v1;
                    if (BF) { const u32x4 r = *(const u32x4*)(xb + o); v0 = (f32x4){bf2f((unsigned short)(r.x & 0xffff)), bf2f((unsigned short)(r.x >> 16)), bf2f((unsigned short)(r.y & 0xffff)), bf2f((unsigned short)(r.y >> 16))};
                        v1 = (f32x4){bf2f((unsigned short)(r.z & 0xffff)), bf2f((unsigned short)(r.z >> 16)), bf2f((unsigned short)(r.w & 0xffff)), bf2f((unsigned short)(r.w >> 16))}; }
                    else { v0 = __builtin_nontemporal_load((const f32x4*)(base_f + o)); v1 = __builtin_nontemporal_load((const f32x4*)(base_f + o + 4)); }
                    v0 += acc[ai][bj][m][0]; v1 += acc[ai][bj][m][1];
                    *(u32x4*)(xb + o) = (u32x4){cvt_pk_bf16(v0.x, v0.y), cvt_pk_bf16(v0.z, v0.w), cvt_pk_bf16(v1.x, v1.y), cvt_pk_bf16(v1.z, v1.w)}; }
                if (BF ? (m == 3) : (m & 1)) asm volatile("" ::: "memory");
            }
    }
};
struct EpiWin1 {
    const float* rstd; const f32x2* cs32; bf16_t* z1; bf16_t* kr; LAS float* stat;
    __device__ __forceinline__ void operator()(AccRef acc, const Unit& u, int wr, int wc, int fr, int fq) const {
        const int pn = u.pn; const int nbj = (pn == 0) ? 2 : 1;
#pragma unroll
        for (int ai = 0; ai < 2; ++ai)
#pragma unroll
            for (int m = 0; m < 4; ++m) {
                const int rl = ai * HALF + wr * 64 + m * 16 + fr; const float rs = rstd[u.pm * BM + rl];
                float s = 0.f;
#pragma unroll
                for (int bj = 0; bj < 2; ++bj) if (bj < nbj)
#pragma unroll
                    for (int n = 0; n < 2; ++n) { const f32x4 x = acc[ai][bj][m][n] * rs; s += (x.x * x.x + x.y * x.y) + (x.z * x.z + x.w * x.w); }
                s += __shfl_xor(s, 16); s += __shfl_xor(s, 32);
                if (fq == 0) stat[rl * 4 + wc] = s;
            }
        asm volatile("s_waitcnt lgkmcnt(0)" ::: "memory"); __builtin_amdgcn_s_barrier(); asm volatile("" ::: "memory");
#pragma unroll
        for (int ai = 0; ai < 2; ++ai)
#pragma unroll
            for (int m = 0; m < 4; ++m) {
                const int rl = ai * HALF + wr * 64 + m * 16 + fr, r = u.pm * BM + rl, t = r & (SEQ - 1); const float rs = rstd[r];
                const f32x4 st = *(const LAS f32x4*)(stat + rl * 4);
                const float ssq = (st.x + st.y) + (st.z + st.w);
                const float rn = rs / sqrtf(ssq * (pn == 0 ? (1.0f / 256.0f) : (1.0f / 128.0f)) + NORM_EPS);
#pragma unroll
                for (int bj = 0; bj < 2; ++bj) if (bj < nbj) { const f32x4 v0 = acc[ai][bj][m][0] * rn, v1 = acc[ai][bj][m][1] * rn;
                        *(u32x4*)(z1 + (size_t)r * ODD_INP + pn * BM + bj * HALF + wc * 32 + 8 * fq) = (u32x4){cvt_pk_bf16(v0.x, v0.y), cvt_pk_bf16(v0.z, v0.w), cvt_pk_bf16(v1.x, v1.y), cvt_pk_bf16(v1.z, v1.w)}; }
                if (pn == 1 && wc == 0) {
                    const f32x4 a = *(const f32x4*)(cs32 + t * 16 + 4 * fq), b = *(const f32x4*)(cs32 + t * 16 + 4 * fq + 2);
                    const f32x4 c4 = {a.x, a.z, b.x, b.z}, s4 = {a.y, a.w, b.y, b.w};
                    const f32x4 x1 = acc[ai][1][m][0] * rs, x2 = acc[ai][1][m][1] * rs, y1 = x1 * c4 - x2 * s4, y2 = x1 * s4 + x2 * c4;
                    u32x2 w1, w2; w1.x = cvt_pk_bf16(y1.x, y1.y); w1.y = cvt_pk_bf16(y1.z, y1.w); w2.x = cvt_pk_bf16(y2.x, y2.y); w2.y = cvt_pk_bf16(y2.z, y2.w);
                    *(u32x2*)(kr + (size_t)r * 32 + 4 * fq) = w1; *(u32x2*)(kr + (size_t)r * 32 + 16 + 4 * fq) = w2;
                }
            }
    }
};
struct EpiQup {
    const f32x2* cs32; bf16_t* q1;
    __device__ __forceinline__ void operator()(AccRef acc, const Unit& u, int wr, int wc, int fr, int fq) const {
        const int pn = u.pn;
#pragma unroll
        for (int ai = 0; ai < 2; ++ai)
#pragma unroll
            for (int m = 0; m < 4; ++m) {
                const int r = u.pm * BM + ai * HALF + wr * 64 + m * 16 + fr, t = r & (SEQ - 1);
                bf16_t* row = q1 + (size_t)r * 1536;
                if (pn < 4) {
#pragma unroll
                    for (int bj = 0; bj < 2; ++bj) { const f32x4 v0 = acc[ai][bj][m][0] * C2_96, v1 = acc[ai][bj][m][1] * C2_96;
                            const int head = pn * 4 + bj * 2 + (wc >> 1), d = 32 * (wc & 1) + 8 * fq;
                            *(u32x4*)(row + head * 96 + d) = (u32x4){cvt_pk_bf16(v0.x, v0.y), cvt_pk_bf16(v0.z, v0.w), cvt_pk_bf16(v1.x, v1.y), cvt_pk_bf16(v1.z, v1.w)}; }
                } else {
                    const f32x4 a = *(const f32x4*)(cs32 + t * 16 + 4 * fq), b = *(const f32x4*)(cs32 + t * 16 + 4 * fq + 2);
                    const f32x4 c4 = {a.x, a.z, b.x, b.z}, s4 = {a.y, a.w, b.y, b.w};
#pragma unroll
                    for (int bj = 0; bj < 2; ++bj) { const f32x4 x1 = acc[ai][bj][m][0] * C2_96, x2 = acc[ai][bj][m][1] * C2_96, y1 = x1 * c4 - x2 * s4, y2 = x1 * s4 + x2 * c4;
                        u32x2 w1, w2; w1.x = cvt_pk_bf16(y1.x, y1.y); w1.y = cvt_pk_bf16(y1.z, y1.w); w2.x = cvt_pk_bf16(y2.x, y2.y); w2.y = cvt_pk_bf16(y2.z, y2.w);
                        const int head = (pn - 4) * 8 + bj * 4 + wc; *(u32x2*)(row + head * 96 + 64 + 4 * fq) = w1; *(u32x2*)(row + head * 96 + 80 + 4 * fq) = w2; }
                }
            }
    }
};
struct EpiKvup {
    bf16_t* kn1; bf16_t* v1;
    __device__ __forceinline__ void operator()(AccRef acc, const Unit& u, int wr, int wc, int fr, int fq) const {
#pragma unroll
        for (int ai = 0; ai < 2; ++ai)
#pragma unroll
            for (int m = 0; m < 4; ++m) {
                const size_t r = (size_t)(u.pm * BM + ai * HALF + wr * 64 + m * 16 + fr);
#pragma unroll
                for (int bj = 0; bj < 2; ++bj) { const f32x4 v0 = acc[ai][bj][m][0], vv = acc[ai][bj][m][1];
                        const int head = u.pn * 2 + bj, j = wc * 32 + 8 * fq;
                        bf16_t* dst = (wc < 2) ? (kn1 + r * 1024 + head * 64 + j) : (v1 + r * 1024 + head * 64 + (j - 64));
                        *(u32x4*)dst = (u32x4){cvt_pk_bf16(v0.x, v0.y), cvt_pk_bf16(v0.z, v0.w), cvt_pk_bf16(vv.x, vv.y), cvt_pk_bf16(vv.z, vv.w)}; }
            }
    }
};
}

__device__ __forceinline__ void moe_tables(LAS unsigned char* lds, const int* cntg) {
    LAS int* cnt = (LAS int*)(lds + LDS_MISC + LM_CNT); LAS int* pbase = (LAS int*)(lds + LDS_MISC + LM_PBASE);
    const int tid_m = my_tid();
    if (tid_m < 32) cnt[tid_m] = cntg[tid_m];
    __syncthreads();
    if (tid_m == 0) { int p = 0; for (int e = 0; e < 32; ++e) { pbase[e] = p; p += (cnt[e] + 255) >> 8; } pbase[32] = p; }
    __syncthreads();
}
template <bool GATHER_> struct MoeSched {
    static constexpr bool GATHER = GATHER_;
    const char* A; const char* Bt; LAS const int* cnt; LAS const int* pbase; LAS const unsigned* rowoff; unsigned lda_b, K2; int upp, G, c;
    __device__ __forceinline__ bool next(int i, pg8::Unit& u) const {
        const int L = i * G + c, total = pbase[32] * upp; if (L >= total) return false;
        const int pg = L / upp, sub = L - pg * upp; int e = 0;
        for (int j = 1; j < 32; ++j) e = (pbase[j] <= pg) ? j : e;
        u.e = e; u.panel = pg - pbase[e]; u.pm = pg; u.pn = sub; const int rem = cnt[e] - u.panel * 256; u.nrows = rem < 256 ? rem : 256; u.slot = i; return true;
    }
    __device__ __forceinline__ const char* abase(const pg8::Unit& u) const { return GATHER ? A : A + (size_t)u.pm * 256 * lda_b; }
    __device__ __forceinline__ unsigned lda() const { return lda_b; }
    __device__ __forceinline__ unsigned arow(const pg8::Unit& u, int R) const { return rowoff[(u.slot & 7) * 256 + R]; }
    __device__ __forceinline__ const char* bbase(const pg8::Unit& u) const { return Bt + ((size_t)u.e * upp + u.pn) * (256 * (size_t)K2); }
};
namespace pg8 {
struct EpiMoeUp {
    const int* list; const float* rstd; bf16_t* H;
    __device__ __forceinline__ void operator()(AccRef acc, const Unit& u, int wr, int wc, int fr, int fq) const {
#pragma unroll
        for (int ai = 0; ai < 2; ++ai)
#pragma unroll
            for (int m = 0; m < 4; ++m) {
                const int rl = ai * HALF + wr * 64 + m * 16 + fr; const bool valid = rl < u.nrows;
                const int tok = valid ? (list[(size_t)u.e * NT + u.panel * 256 + rl] >> 1) : 0; const float rs = rstd[tok];
                u32x4 w4;
#pragma unroll
                for (int n = 0; n < 2; ++n) { const f32x4 g = acc[ai][0][m][n] * rs, up = acc[ai][1][m][n] * rs; f32x4 h;
#pragma unroll
                    for (int j = 0; j < 4; ++j) h[j] = g[j] * up[j] * __builtin_amdgcn_rcpf(1.0f + __builtin_amdgcn_exp2f(-g[j] * LOG2E));
                    w4[2 * n] = cvt_pk_bf16(h.x, h.y); w4[2 * n + 1] = cvt_pk_bf16(h.z, h.w); }
                *(u32x4*)(H + (size_t)(u.pm * 256 + rl) * FF + u.pn * HALF + wc * 32 + 8 * fq) = w4;
            }
    }
};
struct EpiMoeDn {
    const int* list; const float* gw; bf16_t* Y;
    __device__ __forceinline__ void operator()(AccRef acc, const Unit& u, int wr, int wc, int fr, int fq) const {
#pragma unroll
        for (int ai = 0; ai < 2; ++ai)
#pragma unroll
            for (int m = 0; m < 4; ++m) {
                const int rl = ai * HALF + wr * 64 + m * 16 + fr;
                if (rl < u.nrows) {
                    const int entry = list[(size_t)u.e * NT + u.panel * 256 + rl]; const float w8 = gw[entry];
#pragma unroll
                    for (int bj = 0; bj < 2; ++bj) { const f32x4 v0 = acc[ai][bj][m][0] * w8, v1 = acc[ai][bj][m][1] * w8;
                            *(u32x4*)(Y + (size_t)entry * DM + u.pn * BM + bj * HALF + wc * 32 + 8 * fq) = (u32x4){cvt_pk_bf16(v0.x, v0.y), cvt_pk_bf16(v0.z, v0.w), cvt_pk_bf16(v1.x, v1.y), cvt_pk_bf16(v1.z, v1.w)}; }
                }
            }
    }
};
}

constexpr int RT_WSTRIDE = 2064;
__device__ __forceinline__ void route_phase(LAS unsigned char* lds, const bf16_t* xb, const bf16_t* wrt, const float* bg, const float* be, float* rstd_out, int* cntg, int* list, float* gw, int G, int c) {
    const int tid = my_tid(), wid = __builtin_amdgcn_readfirstlane(tid >> 6), lane = tid & 63;
    LAS int* lcnt = (LAS int*)(lds + LDS_MISC + LM_LCNT); LAS int* lbase = lcnt + 32;
    for (int i = tid; i < 48 * 128; i += NTHREADS) { const int r = i >> 7, ch = i & 127; *(LAS u32x4*)(lds + r * RT_WSTRIDE + ch * 16) = *(const u32x4*)(wrt + (size_t)r * DM + ch * 8); }
    if (tid < 32) lcnt[tid] = 0;
    __syncthreads();
    LAS float* lg = (LAS float*)(lds + 102400 + wid * 3072);
    for (int item = c; item < NT / 128; item += G) {
        const int tok0 = item * 128 + wid * 16;
        f32x4 acc[3] = {(f32x4){0.f, 0.f, 0.f, 0.f}, (f32x4){0.f, 0.f, 0.f, 0.f}, (f32x4){0.f, 0.f, 0.f, 0.f}};
        float ss = 0.f;
        const bf16_t* xr = xb + (size_t)(tok0 + (lane & 15)) * DM + 8 * (lane >> 4);
        const LAS unsigned char* wl = lds + (lane & 15) * RT_WSTRIDE + 16 * (lane >> 4);
#pragma unroll 4
        for (int s = 0; s < 32; ++s) {
            const bf16x8 a = *(const bf16x8*)(xr + 32 * s);
#pragma unroll
            for (int j = 0; j < 8; ++j) { const float f = bf2f((unsigned short)a[j]); ss = fmaf(f, f, ss); }
#pragma unroll
            for (int ct = 0; ct < 3; ++ct) { const bf16x8 b = *(const LAS bf16x8*)(wl + ct * 16 * RT_WSTRIDE + 64 * s); acc[ct] = __builtin_amdgcn_mfma_f32_16x16x32_bf16(a, b, acc[ct], 0, 0, 0); }
        }
        ss += __shfl_xor(ss, 16); ss += __shfl_xor(ss, 32);
        const float rs = 1.0f / sqrtf(ss * (1.0f / DM) + NORM_EPS);
#pragma unroll
        for (int ct = 0; ct < 3; ++ct)
#pragma unroll
            for (int j = 0; j < 4; ++j) lg[(4 * (lane >> 4) + j) * 48 + ct * 16 + (lane & 15)] = acc[ct][j];
        asm volatile("s_waitcnt lgkmcnt(0)" ::: "memory");
        int e0 = 0, e1 = 0, lp0 = 0, lp1 = 0; float w0 = 0.f, w1 = 0.f;
        if (lane < 16) {
            const LAS float* l = lg + lane * 48;
            float g4[4];
#pragma unroll
            for (int g = 0; g < 4; ++g) g4[g] = l[g] * rs + bg[g];
            int grp = 0; float gm = g4[0];
#pragma unroll
            for (int g = 1; g < 4; ++g) if (g4[g] > gm) { gm = g4[g]; grp = g; }
            float gs = 0.f;
#pragma unroll
            for (int g = 0; g < 4; ++g) gs += expf(g4[g] - gm);
            const float pgp = 1.0f / gs;
            float el[8];
#pragma unroll
            for (int i = 0; i < 8; ++i) el[i] = l[4 + grp * 8 + i] * rs + be[grp * 8 + i];
            int i0 = 0; float v0 = el[0];
#pragma unroll
            for (int i = 1; i < 8; ++i) if (el[i] > v0) { v0 = el[i]; i0 = i; }
            int i1 = -1; float v1 = -INFINITY;
#pragma unroll
            for (int i = 0; i < 8; ++i) if (i != i0 && el[i] > v1) { v1 = el[i]; i1 = i; }
            const float ex = expf(v1 - v0); w0 = pgp / (1.0f + ex); w1 = pgp * ex / (1.0f + ex);
            e0 = grp * 8 + i0; e1 = grp * 8 + i1;
            lp0 = __hip_atomic_fetch_add(lcnt + e0, 1, __ATOMIC_RELAXED, __HIP_MEMORY_SCOPE_WORKGROUP);
            lp1 = __hip_atomic_fetch_add(lcnt + e1, 1, __ATOMIC_RELAXED, __HIP_MEMORY_SCOPE_WORKGROUP);
            rstd_out[tok0 + lane] = rs; gw[(tok0 + lane) * 2] = w0; gw[(tok0 + lane) * 2 + 1] = w1;
        }
        __syncthreads();
        if (tid < 32) { const int n = lcnt[tid]; lbase[tid] = n ? atomicAdd(cntg + tid, n) : 0; }
        __syncthreads();
        if (lane < 16) { list[(size_t)e0 * NT + lbase[e0] + lp0] = (tok0 + lane) * 2; list[(size_t)e1 * NT + lbase[e1] + lp1] = (tok0 + lane) * 2 + 1; }
        __syncthreads();
        if (tid < 32) lcnt[tid] = 0;
        __syncthreads();
    }
}

namespace att {
typedef short s16x4 __attribute__((ext_vector_type(4)));
constexpr float THR = 8.0f;
__device__ __forceinline__ int crow(int r, int hi) { return (r & 3) + 8 * (r >> 2) + 4 * hi; }
__device__ __forceinline__ void glds16(const void* gsrc, unsigned lds_dst) { unsigned keep;
    asm volatile("s_mov_b32 %0, m0\n\ts_mov_b32 m0, %2\n\ts_nop 0\n\tglobal_load_lds_dwordx4 %1, off\n\ts_mov_b32 m0, %0" : "=&s"(keep) : "v"(gsrc), "s"(lds_dst) : "memory"); }
__device__ __forceinline__ void glds16s(const void* sbase, unsigned voff, unsigned lds_dst) { unsigned keep;
    asm volatile("s_mov_b32 %0, m0\n\ts_mov_b32 m0, %3\n\ts_nop 0\n\tglobal_load_lds_dwordx4 %1, %2\n\ts_mov_b32 m0, %0" : "=&s"(keep) : "v"(voff), "s"(sbase), "s"(lds_dst) : "memory"); }
__device__ __forceinline__ s16x4 vtr(LAS const unsigned char* p) { typedef short v4i16_t __attribute__((ext_vector_type(4))); return __builtin_bit_cast(s16x4, __builtin_amdgcn_ds_read_tr16_b64_v4i16((LAS v4i16_t*)p)); }
__device__ __forceinline__ float max3f(float a, float b, float c) { float r; asm("v_max3_f32 %0, %1, %2, %3" : "=v"(r) : "v"(a), "v"(b), "v"(c)); return r; }
__device__ __forceinline__ float max2f(float a, float b) { float r; asm("v_max_f32_e32 %0, %1, %2" : "=v"(r) : "v"(a), "v"(b)); return r; }
#ifndef ATT_STAGGER
#define ATT_STAGGER 1
#endif
#define ATT_WAITBAR() asm volatile("s_waitcnt vmcnt(0) lgkmcnt(0)\n\ts_barrier" ::: "memory")

template <int DK, int DV, int MODE, bool LAG>
__device__ __forceinline__ bool attn_unit(LAS unsigned char* kv, LAS float* wsf, const bf16_t* qrow, const bf16_t* Kb, int ldk, const bf16_t* Krb, const bf16_t* Vb, int ldv,
                                          int qb, unsigned sel, f32x16 (&o)[DV / 32], float& m_out, float& l_out) {
    constexpr int KB = DK * 128, VB = DV * 128, NKC = DK / 8, NVP = DV / 8;
    constexpr bool NEGM = (DV <= 64) || LAG;
    int tid_o = my_tid(); asm volatile("" : "+v"(tid_o));
    const int tid = tid_o, lane = tid & 63, r32 = lane & 31, hi = lane >> 5; const int wid = __builtin_amdgcn_readfirstlane(tid >> 6);
    const unsigned lds0 = (unsigned)(uintptr_t)kv;
    bf16x8 qr[DK / 16];
#pragma unroll
    for (int d0 = 0; d0 < DK / 16; ++d0) qr[d0] = __builtin_nontemporal_load((const bf16x8*)(qrow + d0 * 16 + hi * 8));
    const f32x16 zero16 = (f32x16){0.f, 0.f, 0.f, 0.f, 0.f, 0.f, 0.f, 0.f, 0.f, 0.f, 0.f, 0.f, 0.f, 0.f, 0.f, 0.f};
#pragma unroll
    for (int d = 0; d < DV / 32; ++d) o[d] = zero16;
    float m_run = 0.f, l_run = 0.f, lsa = 0.f, lsb = 0.f;
    f32x16 negm = zero16;
    const int NT = (MODE >= 2) ? 4 : 4 * (qb + 1);
    auto dma_k = [&](int kv0, int buf) {
        { const bf16_t* src = Kb + (size_t)kv0 * ldk + wid * 8; glds16s(src, (unsigned)(lane * ldk) * 2u, (unsigned)__builtin_amdgcn_readfirstlane(lds0 + buf * KB + wid * 1024)); }
        if (NKC == 12 && wid < 4) { const bf16_t* src = Krb + (size_t)kv0 * 32 + wid * 8; glds16s(src, (unsigned)lane * 64u, (unsigned)__builtin_amdgcn_readfirstlane(lds0 + buf * KB + (8 + wid) * 1024)); }
    };
    auto dma_v = [&](int kv0, int buf) {
#pragma unroll
        for (int pp = 0; pp < NVP / 8; ++pp) { const int pc = wid + 8 * pp, db = pc >> 2, rg = pc & 3;
            const bf16_t* src = Vb + (size_t)(kv0 + 16 * rg) * ldv + db * 32; glds16s(src, (unsigned)((lane >> 2) * ldv + (lane & 3) * 8) * 2u, (unsigned)__builtin_amdgcn_readfirstlane(lds0 + 2 * KB + buf * VB + pc * 1024)); }
    };
    auto tile_kv0 = [&](int i) -> int { if (MODE == 0) return 64 * i; if (MODE >= 2) return 256 * qb + 64 * i; return (i < 4) ? 256 * qb + 64 * i : 64 * (i - 4); };
    auto tile_jd = [&](int i) -> int { if (MODE == 0) return (i >= 4 * qb) ? i - 4 * qb : -1; if (MODE == 2) return i; if (MODE == 3) return -1; return (i < 4) ? i : -1; };
    auto qkt = [&](f32x16& p0, f32x16& p1, int buf, const f32x16& c0) {
        LAS const unsigned char* Kt = kv + buf * KB + hi * 1024 + r32 * 16;
#pragma unroll
        for (int d0 = 0; d0 < DK / 16; ++d0) {
            const bf16x8 k0 = *(LAS const bf16x8*)(Kt + d0 * 2048), k1 = *(LAS const bf16x8*)(Kt + d0 * 2048 + 512);
            if (d0 == 0) { p0 = __builtin_amdgcn_mfma_f32_32x32x16_bf16(k0, qr[0], c0, 0, 0, 0); p1 = __builtin_amdgcn_mfma_f32_32x32x16_bf16(k1, qr[0], c0, 0, 0, 0); }
            else { p0 = __builtin_amdgcn_mfma_f32_32x32x16_bf16(k0, qr[d0], p0, 0, 0, 0); p1 = __builtin_amdgcn_mfma_f32_32x32x16_bf16(k1, qr[d0], p1, 0, 0, 0); }
        }
    };
    auto cmask = [&](f32x16& p0, f32x16& p1, int jd) { const int rel = 64 * jd - 32 * wid;
        if (rel + 63 > 0) { const int d = r32 - rel - 4 * hi;
#pragma unroll
            for (int r = 0; r < 16; ++r) { const int c = (r & 3) + 8 * (r >> 2); if (c > d) p0[r] = -INFINITY; if (c + 32 > d) p1[r] = -INFINITY; } } };
    auto rowmax = [&](const f32x16& p0, const f32x16& p1) -> float {
        float a = max3f(p0[0], p0[1], p1[0]), b = max3f(p0[2], p0[3], p1[1]); a = max3f(a, p1[2], p1[3]);
#pragma unroll
        for (int r = 4; r < 16; r += 4) { a = max3f(a, p0[r], p0[r + 1]); b = max3f(b, p0[r + 2], p0[r + 3]); a = max3f(a, p1[r], p1[r + 1]); b = max3f(b, p1[r + 2], p1[r + 3]); }
        const float mx = max2f(a, b);
        auto rr = __builtin_amdgcn_permlane32_swap(__float_as_uint(mx), __float_as_uint(mx), false, false); return max2f(__uint_as_float(rr[0]), __uint_as_float(rr[1])); };
    dma_k(tile_kv0(0), 0);
    ATT_WAITBAR();
    f32x16 pA0 = zero16, pA1 = zero16, pB0 = zero16, pB1 = zero16;
#define ATT_SB() __builtin_amdgcn_sched_barrier(0)
#define ATT_PIN(x) asm volatile("" : "+v"(x))
#define ATT_SUMPACK(P0, P1, i) do { constexpr int e_ = ((i) & 3) * 4; \
        if ((i) < 4) { psa += P0[e_] + P0[e_ + 1]; psb += P0[e_ + 2] + P0[e_ + 3]; pw[(i) >> 1][2 * ((i) & 1)] = cvt_pk_bf16(P0[e_], P0[e_ + 1]); pw[(i) >> 1][2 * ((i) & 1) + 1] = cvt_pk_bf16(P0[e_ + 2], P0[e_ + 3]); } \
        else { psa += P1[e_] + P1[e_ + 1]; psb += P1[e_ + 2] + P1[e_ + 3]; pw[(i) >> 1][2 * ((i) & 1)] = cvt_pk_bf16(P1[e_], P1[e_ + 1]); pw[(i) >> 1][2 * ((i) & 1) + 1] = cvt_pk_bf16(P1[e_ + 2], P1[e_ + 3]); } \
        if (MODE == 1) { pw[(i) >> 1][2 * ((i) & 1)] = rowok_p ? pw[(i) >> 1][2 * ((i) & 1)] : 0u; pw[(i) >> 1][2 * ((i) & 1) + 1] = rowok_p ? pw[(i) >> 1][2 * ((i) & 1) + 1] : 0u; } \
        ATT_PIN(psa); ATT_PIN(psb); ATT_PIN(pw[(i) >> 1]); } while (0)
#define ATT_EXP(S0, S1, i) do { constexpr int e_ = ((i) & 3) * 4; \
        if ((i) < 4) { _Pragma("unroll") for (int j_ = 0; j_ < 4; ++j_) S0[e_ + j_] = __builtin_amdgcn_exp2f(NEGM ? S0[e_ + j_] : S0[e_ + j_] - m_run); ATT_PIN(S0); } \
        else { _Pragma("unroll") for (int j_ = 0; j_ < 4; ++j_) S1[e_ + j_] = __builtin_amdgcn_exp2f(NEGM ? S1[e_ + j_] : S1[e_ + j_] - m_run); ATT_PIN(S1); } } while (0)
#define ATT_KLD(i) (*(LAS const bf16x8*)(Kt_ + ((i) >> 1) * 2048 + ((i) & 1) * 512))
#define ATT_VLD(j) do { const int db_ = (j) >> 2, ks_ = (j) & 3; vlo[(j) & 7] = vtr(Vt_ + db_ * 4096 + ks_ * 1024); vhi[(j) & 7] = vtr(Vt_ + db_ * 4096 + ks_ * 1024 + 512); } while (0)
#define ATT_QK(P0, P1, S0, S1, i, HASPV) do { if ((i) + 2 < NMF) kf[((i) + 2) % 3] = ATT_KLD((i) + 2); \
        if ((i) & 1) S1 = __builtin_amdgcn_mfma_f32_32x32x16_bf16(kf[(i) % 3], qr[(i) >> 1], (i) == 1 ? ci : S1, 0, 0, 0); \
        else S0 = __builtin_amdgcn_mfma_f32_32x32x16_bf16(kf[(i) % 3], qr[(i) >> 1], (i) == 0 ? ci : S0, 0, 0, 0); \
        if (HASPV && (i) < 8) { ATT_VLD(i); if (LAG || (i) < 6) ATT_SUMPACK(P0, P1, i); } \
        ATT_SB(); } while (0)
#define ATT_PV(S0, S1, j, HASQK) do { \
        { const s16x4 lo_ = vlo[(j) & 7], hh_ = vhi[(j) & 7]; const bf16x8 vf_ = (bf16x8){lo_[0], lo_[1], lo_[2], lo_[3], hh_[0], hh_[1], hh_[2], hh_[3]}; \
          o[(j) >> 2] = __builtin_amdgcn_mfma_f32_32x32x16_bf16(__builtin_bit_cast(bf16x8, pw[(j) & 3]), vf_, o[(j) >> 2], 0, 0, 0); } \
        if ((j) + 8 < NPV) ATT_VLD((j) + 8); \
        if (HASQK && (j) < 8) ATT_EXP(S0, S1, j); \
        ATT_SB(); } while (0)
#define ATT_STEP(P0, P1, S0, S1, t, HASQK, HASPV) do { \
        constexpr int NMF = DK / 8, NPV = DV / 8; \
        if (HASQK) { if ((t) + 1 < NT) dma_k(tile_kv0((t) + 1), ((t) + 1) & 1); dma_v(tile_kv0(t), (t) & 1); } \
        float psa = LAG ? lsa : 0.f, psb = LAG ? lsb : 0.f; u32x4 pw[4]; s16x4 vlo[8], vhi[8]; \
        const bool rowok_p = (MODE != 1) || ((t) - 1 < 4) || ((sel >> ((((t) - 1 - 4) >> 2) & 31)) & 1u);     \
        const bool rowok_s = (MODE != 1) || ((t) < 4) || ((sel >> ((((t) - 4) >> 2) & 31)) & 1u); \
        LAS const unsigned char* Vt_ = kv + 2 * KB + (((t) + 1) & 1) * VB + ((lane >> 4) & 1) * 32 + (lane & 3) * 8 + (4 * hi + ((lane & 15) >> 2)) * 64;     \
          \
        if (HASQK) { \
            const f32x16 ci = NEGM ? negm : zero16; \
            LAS const unsigned char* Kt_ = kv + ((t) & 1) * KB + hi * 1024 + r32 * 16; \
            bf16x8 kf[3]; kf[0] = ATT_KLD(0); kf[1] = ATT_KLD(1); ATT_SB(); \
            ATT_QK(P0, P1, S0, S1, 0, HASPV); ATT_QK(P0, P1, S0, S1, 1, HASPV); ATT_QK(P0, P1, S0, S1, 2, HASPV); ATT_QK(P0, P1, S0, S1, 3, HASPV); \
            ATT_QK(P0, P1, S0, S1, 4, HASPV); ATT_QK(P0, P1, S0, S1, 5, HASPV); ATT_QK(P0, P1, S0, S1, 6, HASPV); ATT_QK(P0, P1, S0, S1, 7, HASPV); \
            if (NMF == 12) { ATT_QK(P0, P1, S0, S1, 8, HASPV); ATT_QK(P0, P1, S0, S1, 9, HASPV); ATT_QK(P0, P1, S0, S1, 10, HASPV); ATT_QK(P0, P1, S0, S1, 11, HASPV); } \
        } else { ATT_VLD(0); ATT_VLD(1); ATT_VLD(2); ATT_VLD(3); ATT_VLD(4); ATT_VLD(5); ATT_VLD(6); ATT_VLD(7); \
            ATT_SUMPACK(P0, P1, 0); ATT_SUMPACK(P0, P1, 1); ATT_SUMPACK(P0, P1, 2); ATT_SUMPACK(P0, P1, 3); ATT_SUMPACK(P0, P1, 4); ATT_SUMPACK(P0, P1, 5); ATT_SUMPACK(P0, P1, 6); ATT_SUMPACK(P0, P1, 7); } \
        if (!LAG && HASQK && HASPV) { ATT_SUMPACK(P0, P1, 6); ATT_SUMPACK(P0, P1, 7); ATT_SB(); }     \
        if (LAG) { lsa = psa; lsb = psb; } else if (HASPV) l_run += rowok_p ? (psa + psb) : 0.f; \
          \
        bool resc = false; float al = 1.f; \
        if (HASQK && LAG && HASPV) { const int jd_ = tile_jd(t); if (jd_ >= 0) cmask(S0, S1, jd_); }     \
        else if (HASQK) { const int jd_ = tile_jd(t); if (jd_ >= 0) cmask(S0, S1, jd_); \
            asm volatile("s_nop 11" : "+v"(S0), "+v"(S1));     \
            float mx = rowmax(S0, S1); if (!NEGM) mx -= m_run; if (MODE == 1) mx = rowok_s ? mx : -INFINITY; \
            if ((t) == 0 || !__all(mx <= THR)) {                      \
                const float dl = ((t) == 0) ? mx : ((mx > THR) ? mx : 0.f); m_run += dl;     \
                if (NEGM) { _Pragma("unroll") for (int r = 0; r < 16; ++r) { S0[r] -= dl; S1[r] -= dl; negm[r] = -m_run; } } \
                if ((t) != 0) { al = __builtin_amdgcn_exp2f(-dl); l_run *= al; resc = true; } } } \
          \
        if (HASPV) { ATT_SB(); \
            ATT_PV(S0, S1, 0, HASQK); ATT_PV(S0, S1, 1, HASQK); ATT_PV(S0, S1, 2, HASQK); ATT_PV(S0, S1, 3, HASQK); ATT_PV(S0, S1, 4, HASQK); ATT_PV(S0, S1, 5, HASQK); ATT_PV(S0, S1, 6, HASQK); ATT_PV(S0, S1, 7, HASQK); \
            if (NPV == 16) { ATT_PV(S0, S1, 8, HASQK); ATT_PV(S0, S1, 9, HASQK); ATT_PV(S0, S1, 10, HASQK); ATT_PV(S0, S1, 11, HASQK); ATT_PV(S0, S1, 12, HASQK); ATT_PV(S0, S1, 13, HASQK); ATT_PV(S0, S1, 14, HASQK); ATT_PV(S0, S1, 15, HASQK); } \
        } else { ATT_EXP(S0, S1, 0); ATT_EXP(S0, S1, 1); ATT_EXP(S0, S1, 2); ATT_EXP(S0, S1, 3); ATT_EXP(S0, S1, 4); ATT_EXP(S0, S1, 5); ATT_EXP(S0, S1, 6); ATT_EXP(S0, S1, 7); } \
          \
        if (resc) { if (hi == 0) wsf[r32] = al; \
            asm volatile("s_waitcnt lgkmcnt(0)" ::: "memory"); \
            _Pragma("unroll") for (int a_ = 0; a_ < 4; ++a_) { const f32x4 av = *(LAS const f32x4*)(wsf + 8 * a_ + 4 * hi); \
                _Pragma("unroll") for (int d = 0; d < DV / 32; ++d) { o[d][4 * a_ + 0] *= av.x; o[d][4 * a_ + 1] *= av.y; o[d][4 * a_ + 2] *= av.z; o[d][4 * a_ + 3] *= av.w; } } } \
        ATT_WAITBAR(); } while (0)
    ATT_STEP(pB0, pB1, pA0, pA1, 0, true, false);
    int t = 1;
    for (; t + 2 < NT; t += 2) { ATT_STEP(pA0, pA1, pB0, pB1, t, true, true); ATT_STEP(pB0, pB1, pA0, pA1, t + 1, true, true); }
    ATT_STEP(pA0, pA1, pB0, pB1, t, true, true);
    ATT_STEP(pB0, pB1, pA0, pA1, NT, false, true);
#undef ATT_STEP
#undef ATT_PV
#undef ATT_VLD
#undef ATT_QK
#undef ATT_KLD
#undef ATT_EXP
#undef ATT_SUMPACK
#undef ATT_PIN
#undef ATT_SB
    if (LAG) l_run = lsa + lsb;
    { auto rr = __builtin_amdgcn_permlane32_swap(__float_as_uint(l_run), __float_as_uint(l_run), false, false); l_run = __uint_as_float(rr[0]) + __uint_as_float(rr[1]); }
    m_out = m_run; l_out = l_run;
    if (hi == 0) wsf[32 + r32] = __builtin_amdgcn_rcpf(l_run);
    asm volatile("s_waitcnt lgkmcnt(0)" ::: "memory");
#pragma unroll
    for (int a = 0; a < 4; ++a) { const f32x4 av = *(LAS const f32x4*)(wsf + 32 + 8 * a + 4 * hi);
#pragma unroll
        for (int d = 0; d < DV / 32; ++d) { o[d][4 * a + 0] *= av.x; o[d][4 * a + 1] *= av.y; o[d][4 * a + 2] *= av.z; o[d][4 * a + 3] *= av.w; } }
    bool bad_ = false;
    if (LAG) { float os = 0.f;
#pragma unroll
        for (int d = 0; d < DV / 32; ++d)
#pragma unroll
            for (int r = 0; r < 16; ++r) os += __builtin_fabsf(o[d][r]);
        bad_ = !(l_run <= 1e30f) || !(os <= 1e30f); }
    return bad_;
}
template <int DK, int DV, int MODE>
__device__ __forceinline__ void attn_unit_safe(LAS unsigned char* kv, LAS float* wsf, const bf16_t* qrow, const bf16_t* Kb, int ldk, const bf16_t* Krb, const bf16_t* Vb, int ldv,
                                               int qb, unsigned sel, f32x16 (&o)[DV / 32], float& m_out, float& l_out) {
    const bool bad = attn_unit<DK, DV, MODE, true>(kv, wsf, qrow, Kb, ldk, Krb, Vb, ldv, qb, sel, o, m_out, l_out);
    LAS int* flag = (LAS int*)((LAS unsigned char*)lds_raw + LDS_MISC + LM_QSLOT) + 4;
    const int t_ = my_tid();
    if (t_ == 0) *flag = 0;
    __syncthreads();
    if (__builtin_amdgcn_ballot_w64(bad) != 0ull && (t_ & 63) == 0) *flag = 1;
    __syncthreads();
    if (*flag != 0) attn_unit<DK, DV, MODE, false>(kv, wsf, qrow, Kb, ldk, Krb, Vb, ldv, qb, sel, o, m_out, l_out);
}
template <int ND> __device__ __forceinline__ void store_o(const f32x16 (&o)[ND], bf16_t* dst, int ld, int r32, int hi) {
#pragma unroll
    for (int r = 0; r < 16; ++r)
#pragma unroll
        for (int db = 0; db < ND; ++db) dst[(size_t)crow(r, hi) * ld + db * 32 + r32] = (bf16_t)(cvt_pk_bf16(o[db][r], 0.f) & 0xffffu);
}
struct Queue { unsigned* heads; int per; LAS int* slot; int own, cur; };
__device__ __forceinline__ int queue_next(Queue& q) {
    __syncthreads();
    if (my_tid() == 0) { int item = -1;
        while (q.cur < 8) { const int qi = (q.own + q.cur) & 7; const unsigned i = __hip_atomic_fetch_add(q.heads + 64 * qi, 1u, __ATOMIC_RELAXED, __HIP_MEMORY_SCOPE_AGENT);
            if (i < (unsigned)q.per) { item = qi * q.per + (int)i; break; } ++q.cur; }
        q.slot[0] = item; }
    __syncthreads();
    const int it = __builtin_amdgcn_readfirstlane(q.slot[0]);
    return it;
}
}

struct PrepSrc { const float* W; const float* W2; const float* g; };
__device__ __forceinline__ f32x4 prep_fetch4(int mode, const PrepSrc& s, int p, int kk) {
    const f32x4 z = {0.f, 0.f, 0.f, 0.f};
    switch (mode) {
    case 0: return __builtin_nontemporal_load((const f32x4*)(s.W + (size_t)kk * EVEN_IN + win0_truecol(p))) * s.g[kk];
    case 1: return __builtin_nontemporal_load((const f32x4*)(s.W + (size_t)kk * DM + perm8(p)));
    case 2: return (p < ODD_IN) ? __builtin_nontemporal_load((const f32x4*)(s.W + (size_t)kk * ODD_IN + (p < 384 ? perm8(p) : p))) * s.g[kk] : z;
    case 3: return __builtin_nontemporal_load((const f32x4*)(s.W + (size_t)kk * 1536 + qup_truecol(p))) * s.g[kk];
    case 4: return (kk >= 128) ? __builtin_nontemporal_load((const f32x4*)(s.W + (size_t)(kk - 128) * 2048 + perm8(p))) * s.g[kk - 128] : z;
    case 5: { const int e = p >> 9, r = p & 511, hf = r >> 8, rr = r & 255; const ptrdiff_t dlt = (rr < 128) ? (ptrdiff_t)0 : (s.W2 - s.W);
              return __builtin_nontemporal_load((const f32x4*)(s.W + dlt + (ptrdiff_t)(((size_t)e * DM + kk) * FF + hf * 128 + perm8(rr & 127)))) * s.g[kk]; }
    case 6: { const int e = p >> 10, n = perm8(p & 1023); return __builtin_nontemporal_load((const f32x4*)(s.W + ((size_t)e * FF + kk) * DM + n)); }
    default: return (p < 4) ? __builtin_nontemporal_load((const f32x4*)(s.W + (size_t)kk * 4)) * s.g[kk] : (p < 36) ? __builtin_nontemporal_load((const f32x4*)(s.W2 + (size_t)kk * 32 + (p - 4))) * s.g[kk] : z;
    }
}
__device__ __forceinline__ void prep_item(int mode, const PrepSrc& s, bf16_t* out, int P, int Kt, int item, LAS float* scr, int lane) {
    const int nkb = Kt >> 6, pb = item / nkb, kb = item - pb * nkb, p0 = pb * 64, k0 = kb * 64;
#pragma unroll 4
    for (int i = 0; i < 16; ++i) { const int kk = 4 * i + (lane >> 4), n = (lane & 15) * 4; const f32x4 v = prep_fetch4(mode, s, p0 + n, k0 + kk);
        LAS float* t = scr + kk * 64; t[(n + kk) & 63] = v.x; t[(n + 1 + kk) & 63] = v.y; t[(n + 2 + kk) & 63] = v.z; t[(n + 3 + kk) & 63] = v.w; }
    asm volatile("s_waitcnt lgkmcnt(0)" ::: "memory");
    const int c = lane & 7;
#pragma unroll
    for (int j = 0; j < 8; ++j) { const int n = (lane >> 3) + 8 * j; const LAS float* t = scr + (8 * c) * 64; const int b = n + 8 * c;
#define PREP_T(i) t[(i) * 64 + ((b + (i)) & 63)]
        u32x4 o; o.x = cvt_pk_bf16(PREP_T(0), PREP_T(1)); o.y = cvt_pk_bf16(PREP_T(2), PREP_T(3)); o.z = cvt_pk_bf16(PREP_T(4), PREP_T(5)); o.w = cvt_pk_bf16(PREP_T(6), PREP_T(7));
#undef PREP_T
        if (p0 + n < P) *(u32x4*)(out + (size_t)(p0 + n) * Kt + k0 + 8 * c) = o; }
    asm volatile("s_waitcnt lgkmcnt(0)" ::: "memory");
}
__device__ __forceinline__ void prep_matrix(int mode, const float* W, const float* W2, const float* g, bf16_t* out, int P, int Kt, LAS float* scr, int gw, int ngw, int lane, int& off) {
    PrepSrc s{W, W2, g}; const int items = ((P + 63) >> 6) * (Kt >> 6);
    int it = gw - (off % ngw); if (it < 0) it += ngw;
    for (; it < items; it += ngw) prep_item(mode, s, out, P, Kt, it, scr, lane);
    off += items;
}
template <bool XBF> __device__ __forceinline__ void row_phase(const void* xin, const bf16_t* Y, bf16_t* xb, float* rstd, const float* gfin, float* fin, int gw, int ngw, int lane) {
    auto ld = [&](int row, f32x4 (&v)[4]) {
#pragma unroll
        for (int j = 0; j < 4; ++j) {
            if (XBF) { const u32x2 r = *((const u32x2*)((const bf16_t*)xin + (size_t)row * DM) + lane + 64 * j);
                v[j] = (f32x4){bf2f((unsigned short)(r.x & 0xffff)), bf2f((unsigned short)(r.x >> 16)), bf2f((unsigned short)(r.y & 0xffff)), bf2f((unsigned short)(r.y >> 16))}; }
            else v[j] = __builtin_nontemporal_load((const f32x4*)((const float*)xin + (size_t)row * DM) + lane + 64 * j);
            if (Y) {
                const u32x2 y0 = __builtin_nontemporal_load((const u32x2*)(Y + (size_t)(2 * row) * DM) + lane + 64 * j), y1 = __builtin_nontemporal_load((const u32x2*)(Y + (size_t)(2 * row + 1) * DM) + lane + 64 * j);
                v[j].x += bf2f((unsigned short)(y0.x & 0xffff)) + bf2f((unsigned short)(y1.x & 0xffff)); v[j].y += bf2f((unsigned short)(y0.x >> 16)) + bf2f((unsigned short)(y1.x >> 16));
                v[j].z += bf2f((unsigned short)(y0.y & 0xffff)) + bf2f((unsigned short)(y1.y & 0xffff)); v[j].w += bf2f((unsigned short)(y0.y >> 16)) + bf2f((unsigned short)(y1.y >> 16));
            } } };
    auto fn = [&](int row, const f32x4 (&v)[4]) { float s = 0.f;
#pragma unroll
        for (int j = 0; j < 4; ++j) s += (v[j].x * v[j].x + v[j].y * v[j].y) + (v[j].z * v[j].z + v[j].w * v[j].w);
        const float rs = 1.0f / sqrtf(wave_sum(s) * (1.0f / DM) + NORM_EPS);
        if (rstd && lane == 0) rstd[row] = rs;
#pragma unroll
        for (int j = 0; j < 4; ++j) {
            if (xb) { u32x2 w; w.x = cvt_pk_bf16(v[j].x, v[j].y); w.y = cvt_pk_bf16(v[j].z, v[j].w); *((u32x2*)(xb + (size_t)row * DM) + lane + 64 * j) = w; }
            if (fin) { const f32x4 g = *((const f32x4*)gfin + lane + 64 * j); __builtin_nontemporal_store(v[j] * rs * g, (f32x4*)(fin + (size_t)row * DM) + lane + 64 * j); }
        } };
    for (int row = gw; row < NT; row += 2 * ngw) { const int row2 = row + ngw; const bool two = row2 < NT;
        f32x4 va[4], vb[4]; ld(row, va); if (two) ld(row2, vb);
        fn(row, va); if (two) fn(row2, vb); }
}

#define XB_TMO      128
#define XB_XCNT(j)  (256  + 64 * (j))
#define XB_XSUB(j)  (1280 + 64 * (j))
#define XB_XGEN(j)  (2304 + 64 * (j))
#define XB_TOP      3328
#define XB_TOPGEN   3392
#define XCD_BAR_WORDS 3456
#define XB_SPIN_CAP (1u << 18)
__device__ __forceinline__ unsigned xb_ld(unsigned* p)              { return __hip_atomic_load(p, __ATOMIC_RELAXED, __HIP_MEMORY_SCOPE_AGENT); }
__device__ __forceinline__ unsigned xb_add(unsigned* p, unsigned v) { return __hip_atomic_fetch_add(p, v, __ATOMIC_RELAXED, __HIP_MEMORY_SCOPE_AGENT); }
__device__ __forceinline__ unsigned xb_xcc_id() { return (unsigned)__builtin_amdgcn_s_getreg((3 << 11) | 20) & 0xFu; }
#define XB_SPIN(cond, bar) do { unsigned _sp = 0; while (cond) { __builtin_amdgcn_s_sleep(1); \
    if ((++_sp & 255u) == 0u) { if (xb_ld(&(bar)[XB_TMO])) break; if (_sp > XB_SPIN_CAP) { atomicAdd(&(bar)[XB_TMO], 1u); break; } } } } while (0)
struct XcdBarrier { unsigned* bar; unsigned x; volatile LAS unsigned* st; };
__device__ __forceinline__ XcdBarrier xcd_barrier_post(unsigned* bar, volatile LAS unsigned* st) {
    XcdBarrier b; b.bar = bar; b.x = xb_xcc_id(); b.st = st;
    if (my_tid() == 0) (void)xb_add(&bar[XB_XCNT(b.x)], 1u);
    return b;
}
__device__ __forceinline__ void xcd_barrier_complete(unsigned* bar, unsigned x, unsigned& nloc, unsigned& nx) {
    const unsigned G = gridDim.x * gridDim.y * gridDim.z;
    unsigned sum, cnt, mine, sp = 0u;
    for (;;) {
        sum = 0u; cnt = 0u; mine = 0u;
#pragma unroll
        for (unsigned j = 0; j < 16; ++j) { const unsigned c = xb_ld(&bar[XB_XCNT(j)]); sum += c; cnt += (c > 0u) ? 1u : 0u; mine = (j == x) ? c : mine; }
        if (sum == G) break;
        __builtin_amdgcn_s_sleep(1);
        if ((++sp & 255u) == 0u) { if (xb_ld(&bar[XB_TMO])) break; if (sp > XB_SPIN_CAP) { atomicAdd(&bar[XB_TMO], 1u); break; } }
    }
    nloc = mine > 0u ? mine : 1u; nx = cnt > 0u ? cnt : 1u;
}
__device__ __forceinline__ void xcd_barrier(const XcdBarrier& b) {
    asm volatile("s_waitcnt vmcnt(0)" ::: "memory");
    __syncthreads();
    if (my_tid() == 0) {
        unsigned* bar = b.bar;
        __builtin_amdgcn_s_waitcnt(0);
        unsigned nloc = b.st[0], nx = b.st[1];
        if (nloc == 0u) { xcd_barrier_complete(bar, b.x, nloc, nx); b.st[0] = nloc; b.st[1] = nx; }
        const unsigned old = xb_add(&bar[XB_XSUB(b.x)], 1u);
        const unsigned gen = old / nloc;
        if (old + 1u == (gen + 1u) * nloc) {
            __builtin_amdgcn_fence(__ATOMIC_RELEASE, "agent");
            asm volatile("s_waitcnt vmcnt(0)" ::: "memory");
            const unsigned og = xb_add(&bar[XB_TOP], 1u);
            const unsigned tg = og / nx;
            if (og + 1u == (tg + 1u) * nx) xb_add(&bar[XB_TOPGEN], 1u);
            else XB_SPIN(xb_ld(&bar[XB_TOPGEN]) == tg, bar);
            __builtin_amdgcn_fence(__ATOMIC_ACQUIRE, "agent");
            xb_add(&bar[XB_XGEN(b.x)], 1u);
            asm volatile("s_waitcnt vmcnt(0)" ::: "memory");
        } else {
            XB_SPIN(xb_ld(&bar[XB_XGEN(b.x)]) == gen, bar);
            __builtin_amdgcn_fence(__ATOMIC_ACQUIRE, "agent");
            asm volatile("s_waitcnt vmcnt(0)" ::: "memory");
        }
    }
    __syncthreads();
}

constexpr size_t CTL_BAR = 16384;
struct MArgs { const float* in[24]; float* out; unsigned char* ws; int ph_lo, ph_hi; };
typedef __attribute__((address_space(4))) const MArgs* CArgsPtr;
#define PHASE_ENV() CArgsPtr ap_ = (CArgsPtr)__builtin_amdgcn_kernarg_segment_ptr(); asm volatile("" : "+s"(ap_)); unsigned char* const ws = ap_->ws; (void)ws; \
    float* const X = ap_->out; (void)X; float* const rstd = (float*)(ws + WS_RSTD); (void)rstd; bf16_t* const XB = (bf16_t*)(ws + WS_XB); (void)XB; bf16_t* const OMIX = (bf16_t*)(ws + WS_OMIX); (void)OMIX;
#define ARG_IN(k) (ap_->in[k])
template <int rep> __device__ __forceinline__ void ph_prologue(LAS unsigned char* lds, const int G, const int bx) { const int tid = my_tid(); (void)tid; PHASE_ENV();
        const int wv = tid >> 6, lane = tid & 63, gw = bx * NWAVES + wv, ngw = G * NWAVES;
        LAS float* scr = (LAS float*)(lds + wv * 16384); int poff = 0;
        prep_matrix(0, ARG_IN(2), nullptr, ARG_IN(1), (bf16_t*)(ws + WS_W_IN0T), 3072, 1024, scr, gw, ngw, lane, poff);
        prep_matrix(1, ARG_IN(8), nullptr, nullptr, (bf16_t*)(ws + WS_W_OUT0T), 1024, 1024, scr, gw, ngw, lane, poff);
        for (int L = 0; L < 1; ++L) {
            prep_matrix(5, ARG_IN(20) + (size_t)L * NEXP * DM * FF, ARG_IN(21) + (size_t)L * NEXP * DM * FF, ARG_IN(15) + L * DM, (bf16_t*)(ws + WS_W_UPT) + (size_t)L * NEXP * 512 * DM, NEXP * 512, 1024, scr, gw, ngw, lane, poff);
            prep_matrix(6, ARG_IN(22) + (size_t)L * NEXP * FF * DM, nullptr, nullptr, (bf16_t*)(ws + WS_W_DNT) + (size_t)L * NEXP * DM * FF, NEXP * 1024, 256, scr, gw, ngw, lane, poff);
            prep_matrix(7, ARG_IN(16) + (size_t)L * DM * 4, ARG_IN(18) + (size_t)L * DM * 32, ARG_IN(15) + L * DM, (bf16_t*)(ws + WS_W_RT) + (size_t)L * 48 * DM, 48, 1024, scr, gw, ngw, lane, poff);
        }
        { f32x2* cs64 = (f32x2*)(ws + WS_CS64); f32x2* cs32 = (f32x2*)(ws + WS_CS32);
          const int i = tid & 31;
          const float inv = 1.0f / (float)exp(9.210340371976184 * ((double)(2 * i) / 64.0));
          for (int idx = bx * NTHREADS + tid; idx < SEQ * 32; idx += G * NTHREADS) { const int t = idx >> 5;
              const float ang = (float)t * inv; double s, c; sincos_d((double)ang, s, c); const f32x2 v = {(float)c, (float)s}; cs64[idx] = v;
              if (!(i & 1)) cs32[t * 16 + (i >> 1)] = v; } }
        row_phase<false>(ARG_IN(0), nullptr, XB, rstd, nullptr, nullptr, gw, ngw, lane);
    }
template <int CHUNK> __device__ __forceinline__ void ph_prep_late(LAS unsigned char* lds, const int G, const int bx, const int gw, const int ngw) { const int tid = my_tid(); (void)tid; PHASE_ENV();
        const int wv = tid >> 6, lane = tid & 63; LAS float* scr = (LAS float*)(lds + wv * 16384); int poff = 0;
        if (CHUNK == 0) {
            prep_matrix(2, ARG_IN(9), nullptr, ARG_IN(1) + DM, (bf16_t*)(ws + WS_W_IN1T), 512, 1024, scr, gw, ngw, lane, poff);
            prep_matrix(3, ARG_IN(12), nullptr, ARG_IN(10), (bf16_t*)(ws + WS_W_QUPT), 1536, 256, scr, gw, ngw, lane, poff);
            prep_matrix(4, ARG_IN(13), nullptr, ARG_IN(11), (bf16_t*)(ws + WS_W_KVUPT), 2048, 256, scr, gw, ngw, lane, poff);
            prep_matrix(1, ARG_IN(14), nullptr, nullptr, (bf16_t*)(ws + WS_W_OUT1T), 1024, 1024, scr, gw, ngw, lane, poff);
            prep_matrix(7, ARG_IN(16) + (size_t)DM * 4, ARG_IN(18) + (size_t)DM * 32, ARG_IN(15) + DM, (bf16_t*)(ws + WS_W_RT) + (size_t)48 * DM, 48, 1024, scr, gw, ngw, lane, poff); }
        if (CHUNK == 0) prep_matrix(5, ARG_IN(20) + (size_t)NEXP * DM * FF, ARG_IN(21) + (size_t)NEXP * DM * FF, ARG_IN(15) + DM, (bf16_t*)(ws + WS_W_UPT) + (size_t)NEXP * 512 * DM, NEXP * 512, 1024, scr, gw, ngw, lane, poff);
        if (CHUNK == 2) prep_matrix(6, ARG_IN(22) + (size_t)NEXP * FF * DM, nullptr, nullptr, (bf16_t*)(ws + WS_W_DNT) + (size_t)NEXP * DM * FF, NEXP * 1024, 256, scr, gw, ngw, lane, poff);
    }
template <int CHUNK> __device__ __forceinline__ void prep_in_tail(LAS unsigned char* lds, const int G, const int bx, const int U) { const int r = U % G, wv = my_tid() >> 6;
        if ((G - r) * 4 < G) ph_prep_late<CHUNK>(lds, G, bx, bx * NWAVES + wv, G * NWAVES);
        else if (bx >= r) ph_prep_late<CHUNK>(lds, G, bx, (bx - r) * NWAVES + wv, (G - r) * NWAVES); }
template <int rep> __device__ __forceinline__ void ph_win0(LAS unsigned char* lds, const int G, const int bx) { const int tid = my_tid(); (void)tid; PHASE_ENV();
        pg8::DenseSched S; S.init(XB, DM * 2, ws + WS_W_IN0T, NT, EVEN_IN, DM, G, bx);
        pg8::EpiWin0 E{rstd, (const f32x2*)(ws + WS_CS64), (bf16_t*)(ws + WS_QKV0), (float*)(ws + CTL_KMEAN)};
        pg8::gemm_phase<pg8::EpiWin0, pg8::DenseSched, true, true>(lds, DM, S, E);
    }
template <int rep> __device__ __forceinline__ void ph_moba_own(LAS unsigned char* lds, const int G, const int bx) { const int tid = my_tid(); (void)tid; PHASE_ENV();
    att::Queue q; q.heads = (unsigned*)(ws + CTL_Q2 + rep * 4096); q.per = 128; q.slot = (LAS int*)(lds + LDS_MISC + LM_QSLOT); q.own = (int)(xb_xcc_id() & 7u); q.cur = 0;
    const bf16_t* QKV = (const bf16_t*)(ws + WS_QKV0);
    int* lcnt = (int*)(ws + CTL_LCNT); int* lst = (int*)(ws + WS_LST); f32x2* pml = (f32x2*)(ws + WS_PML);
    for (int it = att::queue_next(q); it >= 0; it = att::queue_next(q)) {
        int tid_o = my_tid(); asm volatile("" : "+v"(tid_o)); const int tid_i = tid_o; const int wv = tid_i >> 6, lane = tid_i & 63, r32 = lane & 31, hi = lane >> 5;
        LAS float* wsf = (LAS float*)(lds + LDS_MISC + LM_ATTN) + wv * 64;
        const int g = it >> 7, i = it & 127, mbh = 4 * g + (i >> 5), qb = 31 - (i & 31), b = mbh >> 3, h = mbh & 7;
        const bf16_t* Qw = QKV + ((size_t)b * SEQ + qb * 256) * EVEN_IN + h * 64; const bf16_t* Kb = QKV + (size_t)b * SEQ * EVEN_IN + 512 + h * 64; const bf16_t* Vb = QKV + (size_t)b * SEQ * EVEN_IN + 1024 + h * 64;
        const bf16_t* qrow = Qw + (size_t)(wv * 32 + r32) * EVEN_IN; const int qpos = qb * 256 + wv * 32 + r32;
        LAS float* km = (LAS float*)(lds + 32768);
        { const float* kmg = (const float*)(ws + CTL_KMEAN) + (size_t)(b * 8 + h) * 2048; *(LAS f32x4*)(km + tid_i * 4) = *(const f32x4*)(kmg + tid_i * 4); }
        __syncthreads();
        { float qf[32];
#pragma unroll
          for (int d0 = 0; d0 < 4; ++d0) { const bf16x8 qv = *(const bf16x8*)(qrow + d0 * 16 + hi * 8);
#pragma unroll
              for (int jj = 0; jj < 8; ++jj) qf[d0 * 8 + jj] = bf2f((unsigned short)qv[jj]); }
          float b0 = -INFINITY, b1 = -INFINITY, b2 = -INFINITY; int i0 = -1, i1 = -1, i2 = -1;
          for (int jb = 0; jb < qb; ++jb) { float s = 0.f;
#pragma unroll
              for (int d0 = 0; d0 < 4; ++d0) { const f32x4 k0 = *(LAS const f32x4*)(km + jb * 64 + d0 * 16 + hi * 8), k1 = *(LAS const f32x4*)(km + jb * 64 + d0 * 16 + hi * 8 + 4);
                  s = fmaf(qf[d0 * 8 + 0], k0.x, s); s = fmaf(qf[d0 * 8 + 1], k0.y, s); s = fmaf(qf[d0 * 8 + 2], k0.z, s); s = fmaf(qf[d0 * 8 + 3], k0.w, s);
                  s = fmaf(qf[d0 * 8 + 4], k1.x, s); s = fmaf(qf[d0 * 8 + 5], k1.y, s); s = fmaf(qf[d0 * 8 + 6], k1.z, s); s = fmaf(qf[d0 * 8 + 7], k1.w, s); }
              { auto rr = __builtin_amdgcn_permlane32_swap(__float_as_uint(s), __float_as_uint(s), false, false); s = __uint_as_float(rr[0]) + __uint_as_float(rr[1]); }
              if (s > b0) { b2 = b1; i2 = i1; b1 = b0; i1 = i0; b0 = s; i0 = jb; } else if (s > b1) { b2 = b1; i2 = i1; b1 = s; i1 = jb; } else if (s > b2) { b2 = s; i2 = jb; } }
          LAS int* lc = (LAS int*)(lds + 32768 + 8192); LAS int* lbase = lc + 32;
          if (tid_i < 32) lc[tid_i] = 0;
          __syncthreads();
          int p0 = 0, p1 = 0, p2 = 0;
          if (hi == 0 && rep == 0) { if (i0 >= 0) p0 = __hip_atomic_fetch_add(lc + i0, 1, __ATOMIC_RELAXED, __HIP_MEMORY_SCOPE_WORKGROUP); if (i1 >= 0) p1 = __hip_atomic_fetch_add(lc + i1, 1, __ATOMIC_RELAXED, __HIP_MEMORY_SCOPE_WORKGROUP);
              if (i2 >= 0) p2 = __hip_atomic_fetch_add(lc + i2, 1, __ATOMIC_RELAXED, __HIP_MEMORY_SCOPE_WORKGROUP); }
          __syncthreads();
          const int lb = (b * 8 + h) * 32;
          if (tid_i < 32) { const int n = lc[tid_i]; lbase[tid_i] = n ? atomicAdd(lcnt + lb + tid_i, n) : 0; }
          __syncthreads();
          if (hi == 0 && rep == 0) {
              if (i0 >= 0) lst[lst_base(lb + i0) + lbase[i0] + p0] = (qpos << 2) | 0;
              if (i1 >= 0) lst[lst_base(lb + i1) + lbase[i1] + p1] = (qpos << 2) | 1;
              if (i2 >= 0) lst[lst_base(lb + i2) + lbase[i2] + p2] = (qpos << 2) | 2; } }
        f32x16 o[2]; float mo, lo;
        att::attn_unit_safe<64, 64, 2>(lds, wsf, qrow, Kb, EVEN_IN, nullptr, Vb, EVEN_IN, qb, 0u, o, mo, lo);
        att::store_o<2>(o, OMIX + ((size_t)b * SEQ + qb * 256 + wv * 32) * DM + h * 64, DM, r32, hi);
        if (hi == 0) pml[((size_t)3 * NT + (size_t)b * SEQ + qpos) * 8 + h] = (f32x2){mo, lo};
    }
}
template <int rep> __device__ __forceinline__ void ph_attn0b(LAS unsigned char* lds, const int G, const int bx) { const int tid = my_tid(); (void)tid; PHASE_ENV();
    const bf16_t* QKV = (const bf16_t*)(ws + WS_QKV0);
    const int* lcnt = (const int*)(ws + CTL_LCNT); const int* lst = (const int*)(ws + WS_LST); f32x2* pml = (f32x2*)(ws + WS_PML);
    LAS int* pre = (LAS int*)(lds + LDS_MISC + LM_ROWOFF);
    if (tid < 64) { int c[16]; int sum = 0;
#pragma unroll
        for (int k = 0; k < 16; ++k) { c[k] = (lcnt[tid * 16 + k] + 255) >> 8; sum += c[k]; }
        int inc = sum;
#pragma unroll
        for (int ofs = 1; ofs < 64; ofs <<= 1) { const int v = __shfl_up(inc, ofs); if (tid >= ofs) inc += v; }
        int run = inc - sum;
#pragma unroll
        for (int k = 0; k < 16; ++k) { pre[tid * 16 + k] = run; run += c[k]; }
        if (tid == 63) pre[1024] = run; }
    __syncthreads();
    float lam;
    { const float* lq1 = ARG_IN(3); const float* lk1 = ARG_IN(4); const float* lq2 = ARG_IN(5); const float* lk2 = ARG_IN(6); float s1 = 0.f, s2 = 0.f;
      for (int i = 0; i < 64; ++i) { s1 += lq1[i] * lk1[i]; s2 += lq2[i] * lk2[i]; }
      lam = expf(s1) - expf(s2) + LAM_INIT; }
    unsigned* heads = (unsigned*)(ws + CTL_Q2B + rep * 4096); LAS int* qslot = (LAS int*)(lds + LDS_MISC + LM_QSLOT);
    const int own = (int)(xb_xcc_id() & 7u); int cur = 0;
    for (;;) {
        __syncthreads();
        if (my_tid() == 0) { int item = -1;
            while (cur < 8) { const int qi = (own + cur) & 7; const int per = 64 + (pre[128 * (qi + 1)] - pre[128 * qi]);
                const unsigned i = __hip_atomic_fetch_add(heads + 64 * qi, 1u, __ATOMIC_RELAXED, __HIP_MEMORY_SCOPE_AGENT);
                if (i < (unsigned)per) { item = (qi << 20) | (int)i; break; } ++cur; }
            qslot[0] = item; }
        __syncthreads();
        const int it = __builtin_amdgcn_readfirstlane(qslot[0]); if (it < 0) break;
        int tid_o = my_tid(); asm volatile("" : "+v"(tid_o)); const int tid_i = tid_o; const int wv = tid_i >> 6, lane = tid_i & 63, r32 = lane & 31, hi = lane >> 5;
        LAS float* wsf = (LAS float*)(lds + LDS_MISC + LM_ATTN) + wv * 64;
        const int g = it >> 20, i = it & 0xfffff;
        if (i < 64) {
            const int dbh = 2 * g + (i >> 5), qb = 31 - (i & 31), b = dbh >> 2, h = dbh & 3;
            const bf16_t* Qw = QKV + ((size_t)b * SEQ + qb * 256) * EVEN_IN + 1536 + h * 128; const bf16_t* Kb = QKV + (size_t)b * SEQ * EVEN_IN + 2048 + h * 128; const bf16_t* Vb = QKV + (size_t)b * SEQ * EVEN_IN + 2560 + h * 128;
            LAS unsigned* stash = (LAS unsigned*)(lds + 49152 + wv * 8192);
            f32x16 o[4];
            float mo_, lo_; const bf16_t* qrow = Qw + (size_t)(wv * 32 + r32) * EVEN_IN;
            att::attn_unit_safe<64, 128, 0>(lds, wsf, qrow, Kb, EVEN_IN, nullptr, Vb, EVEN_IN, qb, 0u, o, mo_, lo_);
#pragma unroll
            for (int db = 0; db < 4; ++db)
#pragma unroll
                for (int r = 0; r < 16; r += 2) stash[(db * 8 + (r >> 1)) * 64 + lane] = cvt_pk_bf16(o[db][r], o[db][r + 1]);
            att::attn_unit_safe<64, 128, 0>(lds, wsf, qrow + 64, Kb + 64, EVEN_IN, nullptr, Vb, EVEN_IN, qb, 0u, o, mo_, lo_);
            float ssq[16];
#pragma unroll
            for (int r = 0; r < 16; ++r) ssq[r] = 0.f;
#pragma unroll
            for (int db = 0; db < 4; ++db)
#pragma unroll
                for (int r = 0; r < 16; r += 2) { const unsigned w = stash[(db * 8 + (r >> 1)) * 64 + lane];
                    const float a0 = bf2f((unsigned short)(w & 0xffffu)) - lam * o[db][r], a1 = bf2f((unsigned short)(w >> 16)) - lam * o[db][r + 1];
                    o[db][r] = a0; o[db][r + 1] = a1; ssq[r] += a0 * a0; ssq[r + 1] += a1 * a1; }
            const float* subg = ARG_IN(7);
            float gs[4];
#pragma unroll
            for (int db = 0; db < 4; ++db) gs[db] = subg[db * 32 + r32] * (1.0f - LAM_INIT);
#pragma unroll
            for (int r = 0; r < 16; ++r) { float s = ssq[r];
#pragma unroll
                for (int ofs = 1; ofs < 32; ofs <<= 1) s += __shfl_xor(s, ofs);
                const float rs = 1.0f / sqrtf(s * (1.0f / 128.0f) + NORM_EPS);
#pragma unroll
                for (int db = 0; db < 4; ++db) o[db][r] *= rs * gs[db]; }
            att::store_o<4>(o, OMIX + ((size_t)b * SEQ + qb * 256 + wv * 32) * DM + 512 + h * 128, DM, r32, hi);
        } else {
            const int gc = pre[128 * g] + (i - 64);
            int l = 128 * g; { int lo_ = 128 * g, hi_ = 128 * g + 127;
                while (lo_ < hi_) { const int mid = (lo_ + hi_ + 1) >> 1; if (pre[mid] <= gc) lo_ = mid; else hi_ = mid - 1; } l = __builtin_amdgcn_readfirstlane(lo_); }
            const int ch = gc - pre[l], cnt = lcnt[l], n = (cnt - 256 * ch) < 256 ? (cnt - 256 * ch) : 256;
            const int mbh = l >> 5, jb = l & 31, b = mbh >> 3, h = mbh & 7;
            const int idx = 32 * wv + r32; const bool valid = idx < n;
            const int e = lst[lst_base(l) + 256 * ch + (valid ? idx : 0)];
            const int qpos = e >> 2, sl = e & 3;
            const bf16_t* qrow = QKV + ((size_t)b * SEQ + qpos) * EVEN_IN + h * 64; const bf16_t* Kb = QKV + (size_t)b * SEQ * EVEN_IN + 512 + h * 64; const bf16_t* Vb = QKV + (size_t)b * SEQ * EVEN_IN + 1024 + h * 64;
            f32x16 o[2]; float mo, lo;
            att::attn_unit_safe<64, 64, 3>(lds, wsf, qrow, Kb, EVEN_IN, nullptr, Vb, EVEN_IN, jb, 0u, o, mo, lo);
            LAS int* tab = (LAS int*)wsf;
            if (hi == 0) tab[r32] = valid ? e : -1;
            asm volatile("s_waitcnt lgkmcnt(0)" ::: "memory");
#pragma unroll
            for (int a = 0; a < 4; ++a) { const i32x4 ev = *(LAS const i32x4*)(tab + 8 * a + 4 * hi);
#pragma unroll
                for (int k = 0; k < 4; ++k) { const int ee = (k == 0) ? ev.x : (k == 1) ? ev.y : (k == 2) ? ev.z : ev.w;
                    if (ee >= 0) { const int qq = ee >> 2, ss = ee & 3; bf16_t* dst = (bf16_t*)X + (size_t)ss * NT * 512 + ((size_t)b * SEQ + qq) * 512 + h * 64 + r32;
                        dst[0] = (bf16_t)(cvt_pk_bf16(o[0][4 * a + k], 0.f) & 0xffffu); dst[32] = (bf16_t)(cvt_pk_bf16(o[1][4 * a + k], 0.f) & 0xffffu); } } }
            if (hi == 0 && valid) pml[((size_t)sl * NT + (size_t)b * SEQ + qpos) * 8 + h] = (f32x2){mo, lo};
        }
    }
}
template <int rep> __device__ __forceinline__ void ph_moba_merge(LAS unsigned char* lds, const int G, const int bx) { const int tid = my_tid(); (void)tid; PHASE_ENV();
    const f32x2* pml = (const f32x2*)(ws + WS_PML); const int lane = tid & 63, h = lane >> 3;
    struct Row { f32x2 a3, a[3]; u32x4 v3, v[3]; int np; };
    auto ld = [&](int row, Row& R) { const int qb = (row & (SEQ - 1)) >> 8; R.np = qb < 3 ? qb : 3;
        R.a3 = pml[((size_t)3 * NT + row) * 8 + h]; R.v3 = *(const u32x4*)(OMIX + (size_t)row * DM + lane * 8);
#pragma unroll
        for (int s = 0; s < 3; ++s) if (s < R.np) { R.a[s] = pml[((size_t)s * NT + row) * 8 + h]; R.v[s] = *(const u32x4*)((const bf16_t*)X + (size_t)s * NT * 512 + (size_t)row * 512 + lane * 8); }
                                     else { R.a[s] = (f32x2){-INFINITY, 0.f}; R.v[s] = (u32x4){0u, 0u, 0u, 0u}; } };
    auto fn = [&](int row, const Row& R) { float M = R.a3.x;
#pragma unroll
        for (int s = 0; s < 3; ++s) M = fmaxf(M, R.a[s].x);
        float w3 = R.a3.y * __builtin_amdgcn_exp2f(R.a3.x - M), W = w3; float w[3];
#pragma unroll
        for (int s = 0; s < 3; ++s) { w[s] = (s < R.np) ? R.a[s].y * __builtin_amdgcn_exp2f(R.a[s].x - M) : 0.f; W += w[s]; }
        const float rW = 1.0f / W; float acc[8];
#pragma unroll
        for (int k = 0; k < 4; ++k) { acc[2 * k] = w3 * bf2f((unsigned short)(R.v3[k] & 0xffffu)); acc[2 * k + 1] = w3 * bf2f((unsigned short)(R.v3[k] >> 16)); }
#pragma unroll
        for (int s = 0; s < 3; ++s)
#pragma unroll
            for (int k = 0; k < 4; ++k) { acc[2 * k] += w[s] * bf2f((unsigned short)(R.v[s][k] & 0xffffu)); acc[2 * k + 1] += w[s] * bf2f((unsigned short)(R.v[s][k] >> 16)); }
        bf16_t* op = OMIX + (size_t)row * DM + lane * 8;
        *(u32x4*)(rep ? ((bf16_t*)X + (size_t)3 * NT * 512 + (size_t)row * 512 + lane * 8) : op) = (u32x4){cvt_pk_bf16(acc[0] * rW, acc[1] * rW), cvt_pk_bf16(acc[2] * rW, acc[3] * rW), cvt_pk_bf16(acc[4] * rW, acc[5] * rW), cvt_pk_bf16(acc[6] * rW, acc[7] * rW)}; };
    const int gw = bx * NWAVES + (tid >> 6), ngw = G * NWAVES;
    for (int row = gw; row < NT; row += 2 * ngw) { const int row2 = row + ngw; const bool two = row2 < NT;
        Row A, B; ld(row, A); if (two) ld(row2, B);
        fn(row, A); if (two) fn(row2, B); }
}
template <int rep> __device__ __forceinline__ void ph_wout0(LAS unsigned char* lds, const int G, const int bx) { const int tid = my_tid(); (void)tid; PHASE_ENV();
        pg8::DenseSched S; S.init(OMIX, DM * 2, ws + WS_W_OUT0T, NT, DM, DM, G, bx);
        pg8::EpiWout<false> E{ARG_IN(0), XB};
        pg8::gemm_phase<pg8::EpiWout<false>, pg8::DenseSched, true, true>(lds, DM, S, E);
    }
template <int rep, int L> __device__ __forceinline__ void ph_route(LAS unsigned char* lds, const int G, const int bx) { const int tid = my_tid(); (void)tid; PHASE_ENV(); route_phase(lds, XB, (const bf16_t*)(ws + WS_W_RT) + (size_t)L * 48 * DM, ARG_IN(17) + L * 4, ARG_IN(19) + L * 32, rstd + (L == 0 ? 1 : 3) * NT,
                              (int*)(ws + (L == 0 ? CTL_CNT0 : CTL_CNT1)), (int*)(ws + WS_LIST), (float*)(ws + WS_GW), G, bx); }
template <int rep, int L> __device__ __forceinline__ void ph_moe_up(LAS unsigned char* lds, const int G, const int bx) { const int tid = my_tid(); (void)tid; PHASE_ENV(); moe_tables(lds, (const int*)(ws + (L == 0 ? CTL_CNT0 : CTL_CNT1)));
        MoeSched<true> S; S.A = (const char*)XB; S.Bt = (const char*)(ws + WS_W_UPT) + (size_t)L * NEXP * 512 * DM * 2; S.cnt = (LAS const int*)(lds + LDS_MISC + LM_CNT); S.pbase = (LAS const int*)(lds + LDS_MISC + LM_PBASE);
        S.rowoff = (LAS const unsigned*)(lds + LDS_MISC + LM_ROWOFF); S.lda_b = DM * 2; S.K2 = DM * 2; S.upp = 2; S.G = G; S.c = bx;
        { LAS unsigned* ro = (LAS unsigned*)(lds + LDS_MISC + LM_ROWOFF); const int* list = (const int*)(ws + WS_LIST); pg8::Unit u;
          for (int i = 0; i < 8 && S.next(i, u); ++i) if (tid < 256) { const int pos = u.panel * 256 + tid; ro[i * 256 + tid] = (tid < u.nrows) ? (unsigned)(list[(size_t)u.e * NT + pos] >> 1) * (DM * 2u) : 0u; }
          __syncthreads(); }
        pg8::EpiMoeUp E{(const int*)(ws + WS_LIST), rstd + (L == 0 ? 1 : 3) * NT, (bf16_t*)(ws + WS_H)};
        pg8::gemm_phase<pg8::EpiMoeUp, MoeSched<true>, true, true>(lds, DM, S, E);
        if (rep == 0) { if (L == 0) prep_in_tail<0>(lds, G, bx, S.pbase[32] * 2); else prep_in_tail<2>(lds, G, bx, S.pbase[32] * 2); } }
template <int rep, int L> __device__ __forceinline__ void ph_moe_dn(LAS unsigned char* lds, const int G, const int bx) { const int tid = my_tid(); (void)tid; PHASE_ENV(); moe_tables(lds, (const int*)(ws + (L == 0 ? CTL_CNT0 : CTL_CNT1)));
        MoeSched<false> S; S.A = (const char*)(ws + WS_H); S.Bt = (const char*)(ws + WS_W_DNT) + (size_t)L * NEXP * DM * FF * 2; S.cnt = (LAS const int*)(lds + LDS_MISC + LM_CNT); S.pbase = (LAS const int*)(lds + LDS_MISC + LM_PBASE);
        S.rowoff = (LAS const unsigned*)(lds + LDS_MISC + LM_ROWOFF); S.lda_b = FF * 2; S.K2 = FF * 2; S.upp = 4; S.G = G; S.c = bx;
        pg8::EpiMoeDn E{(const int*)(ws + WS_LIST), (const float*)(ws + WS_GW), (bf16_t*)(ws + WS_Y)};
        pg8::gemm_phase<pg8::EpiMoeDn, MoeSched<false>, true, true>(lds, FF, S, E);
 }
template <int rep> __device__ __forceinline__ void ph_rowpass(LAS unsigned char* lds, const int G, const int bx) { const int tid = my_tid(); (void)tid; PHASE_ENV(); row_phase<true>(XB, (const bf16_t*)(ws + WS_Y), XB, rstd + 2 * NT, nullptr, nullptr, bx * NWAVES + (tid >> 6), G * NWAVES, tid & 63); }
template <int rep> __device__ __forceinline__ void ph_win1(LAS unsigned char* lds, const int G, const int bx) { const int tid = my_tid(); (void)tid; PHASE_ENV();
        pg8::DenseSched S; S.init(XB, DM * 2, ws + WS_W_IN1T, NT, ODD_INP, DM, G, bx);
        pg8::EpiWin1 E{rstd + 2 * NT, (const f32x2*)(ws + WS_CS32), (bf16_t*)(ws + WS_Z1), (bf16_t*)(ws + WS_KR), (LAS float*)(lds + LDS_MISC + LM_STAT)};
        pg8::gemm_phase<pg8::EpiWin1, pg8::DenseSched, true, true>(lds, DM, S, E);
    }
template <int rep> __device__ __forceinline__ void ph_qup(LAS unsigned char* lds, const int G, const int bx) { const int tid = my_tid(); (void)tid; PHASE_ENV();
        pg8::DenseSched S; S.init(ws + WS_Z1, ODD_INP * 2, ws + WS_W_QUPT, NT, 1536, 256, G, bx);
        pg8::EpiQup E{(const f32x2*)(ws + WS_CS32), (bf16_t*)(ws + WS_Q1)};
        pg8::gemm_phase<pg8::EpiQup, pg8::DenseSched, true, true>(lds, 256, S, E);
    }
template <int rep> __device__ __forceinline__ void ph_kvup(LAS unsigned char* lds, const int G, const int bx) { const int tid = my_tid(); (void)tid; PHASE_ENV();
        pg8::DenseSched S; S.init(ws + WS_Z1 + 128 * 2, ODD_INP * 2, ws + WS_W_KVUPT, NT, 2048, 256, G, bx);
        pg8::EpiKvup E{(bf16_t*)(ws + WS_KN1), (bf16_t*)(ws + WS_V1)};
        pg8::gemm_phase<pg8::EpiKvup, pg8::DenseSched, true, true>(lds, 256, S, E);
    }
template <int rep> __device__ __forceinline__ void ph_mla(LAS unsigned char* lds, const int G, const int bx) { const int tid = my_tid(); (void)tid; PHASE_ENV();
        att::Queue q; q.heads = (unsigned*)(ws + CTL_Q10 + rep * 4096); q.per = 256; q.slot = (LAS int*)(lds + LDS_MISC + LM_QSLOT); q.own = (int)(xb_xcc_id() & 7u); q.cur = 0;
        LAS float* wsf = (LAS float*)(lds + LDS_MISC + LM_ATTN) + (tid >> 6) * 64;
        const bf16_t* Q1 = (const bf16_t*)(ws + WS_Q1); const bf16_t* KN1 = (const bf16_t*)(ws + WS_KN1); const bf16_t* KR = (const bf16_t*)(ws + WS_KR); const bf16_t* V1 = (const bf16_t*)(ws + WS_V1);
        for (int it = att::queue_next(q); it >= 0; it = att::queue_next(q)) {
            const int g = it >> 8, i = it & 255, bh = g * 8 + (i >> 5), qb = 31 - (i & 31), b = bh >> 4, h = bh & 15;
            f32x16 o[2];
            float mo_, lo_; att::attn_unit_safe<96, 64, 0>(lds, wsf, Q1 + ((size_t)b * SEQ + qb * 256 + (tid >> 6) * 32 + (tid & 31)) * 1536 + h * 96, KN1 + (size_t)b * SEQ * 1024 + h * 64, 1024, KR + (size_t)b * SEQ * 32, V1 + (size_t)b * SEQ * 1024 + h * 64, 1024, qb, 0u, o, mo_, lo_);
            const int lane = tid & 63;
            att::store_o<2>(o, OMIX + ((size_t)b * SEQ + qb * 256 + (tid >> 6) * 32) * DM + h * 64, DM, lane & 31, lane >> 5);
        }
    }
template <int rep> __device__ __forceinline__ void ph_wout1(LAS unsigned char* lds, const int G, const int bx) { const int tid = my_tid(); (void)tid; PHASE_ENV();
        pg8::DenseSched S; S.init(OMIX, DM * 2, ws + WS_W_OUT1T, NT, DM, DM, G, bx);
        pg8::EpiWout<true> E{nullptr, XB};
        pg8::gemm_phase<pg8::EpiWout<true>, pg8::DenseSched, true, true>(lds, DM, S, E);
    }
template <int rep> __device__ __forceinline__ void ph_final(LAS unsigned char* lds, const int G, const int bx) { const int tid = my_tid(); (void)tid; PHASE_ENV(); row_phase<true>(XB, (const bf16_t*)(ws + WS_Y), nullptr, nullptr, ARG_IN(23), X, bx * NWAVES + (tid >> 6), G * NWAVES, tid & 63); }

#ifndef PROBE_REP
#define PROBE_REP -1
#endif
__global__ void __launch_bounds__(NTHREADS, 2) mega(MArgs args) {
    LAS unsigned char* lds = (LAS unsigned char*)lds_raw;
    const int G = gridDim.x; const int bx = blockIdx.x;
    if (threadIdx.x < 4) ((LAS unsigned*)(lds + LDS_MISC + LM_BAR))[threadIdx.x] = 0u;
    if ((threadIdx.x & 63) == 0) ((LAS int*)(lds + LDS_MISC + LM_WTAB))[hw_wave_slot()] = (int)(threadIdx.x >> 6);
    __syncthreads();
    XcdBarrier bar = xcd_barrier_post((unsigned*)(args.ws + WS_CTL + CTL_BAR), (volatile LAS unsigned*)(lds + LDS_MISC + LM_BAR));
    const int lo = args.ph_lo, hi = args.ph_hi;
#define IN(k) (lo <= (k) && (k) < hi)
#define SEAM(k) do { if (IN(k) && IN((k) + 1)) xcd_barrier(bar); } while (0)
#define RUN(k, CALL0, CALL1) do { if (IN(k)) { CALL0; if (PROBE_REP == (k)) { xcd_barrier(bar); CALL1; } } SEAM(k); } while (0)
    RUN(0, ph_prologue<0>(lds, G, bx), ph_prologue<1>(lds, G, bx));
    RUN(1, ph_win0<0>(lds, G, bx), ph_win0<1>(lds, G, bx));
#ifndef MOBA_SPARSE
#define MOBA_SPARSE 1
#endif
#if MOBA_SPARSE
    if (IN(2)) { ph_moba_own<0>(lds, G, bx); xcd_barrier(bar); if (PROBE_REP == 20) { ph_moba_own<1>(lds, G, bx); xcd_barrier(bar); } ph_attn0b<0>(lds, G, bx); if (PROBE_REP == 21) { xcd_barrier(bar); ph_attn0b<1>(lds, G, bx); } xcd_barrier(bar); if (PROBE_REP == 22) { ph_moba_merge<1>(lds, G, bx); xcd_barrier(bar); } ph_moba_merge<0>(lds, G, bx); }
    SEAM(2);
#endif
    RUN(3, ph_wout0<0>(lds, G, bx), ph_wout0<1>(lds, G, bx));
    RUN(4, (ph_route<0, 0>(lds, G, bx)), (void)0);
    RUN(5, (ph_moe_up<0, 0>(lds, G, bx)), (ph_moe_up<1, 0>(lds, G, bx)));
    RUN(6, (ph_moe_dn<0, 0>(lds, G, bx)), (ph_moe_dn<1, 0>(lds, G, bx)));
    RUN(7, ph_rowpass<0>(lds, G, bx), (void)0);
    RUN(8, ph_win1<0>(lds, G, bx), ph_win1<1>(lds, G, bx));
    if (IN(9)) { ph_qup<0>(lds, G, bx); if (PROBE_REP == 9) { xcd_barrier(bar); ph_qup<1>(lds, G, bx); } }
    if (IN(9)) { ph_kvup<0>(lds, G, bx); if (PROBE_REP == 9) { xcd_barrier(bar); ph_kvup<1>(lds, G, bx); } }
    SEAM(9);
    RUN(10, ph_mla<0>(lds, G, bx), ph_mla<1>(lds, G, bx));
    RUN(11, ph_wout1<0>(lds, G, bx), (void)0);
    RUN(12, (ph_route<0, 1>(lds, G, bx)), (void)0);
    RUN(13, (ph_moe_up<0, 1>(lds, G, bx)), (ph_moe_up<1, 1>(lds, G, bx)));
    RUN(14, (ph_moe_dn<0, 1>(lds, G, bx)), (ph_moe_dn<1, 1>(lds, G, bx)));
    RUN(15, ph_final<0>(lds, G, bx), (void)0);
#undef RUN
#undef IN
#undef SEAM
}

static int g_grid = 0;
extern "C" void kernel_launch(void* const* d_in, const int* in_sizes, int n_in, void* d_out, int out_size, void* d_ws, size_t ws_size, hipStream_t stream) {
    if (n_in != 24 || in_sizes[0] != NT * DM || out_size != NT * DM || ws_size < WS_END) { fprintf(stderr, "kernel_launch: unexpected shapes (n_in %d, ws %zu)\n", n_in, ws_size); return; }
    if (g_grid == 0) {
        int dev = 0, cus = 0;
        if (hipGetDevice(&dev) != hipSuccess || hipDeviceGetAttribute(&cus, hipDeviceAttributeMultiprocessorCount, dev) != hipSuccess) { fprintf(stderr, "device query failed\n"); g_grid = -1; return; }
        if (hipFuncSetAttribute((const void*)mega, hipFuncAttributeMaxDynamicSharedMemorySize, LDS_BYTES) != hipSuccess) { fprintf(stderr, "hipFuncSetAttribute failed\n"); g_grid = -1; return; }
        int per_cu = 0; (void)hipOccupancyMaxActiveBlocksPerMultiprocessor(&per_cu, (const void*)mega, NTHREADS, LDS_BYTES); (void)hipGetLastError();
        g_grid = cus;
    }
    if (g_grid < 0) return;
    (void)hipMemsetAsync((char*)d_ws + WS_CTL, 0, CTL_BYTES, stream);
    MArgs a{}; for (int i = 0; i < 24; ++i) a.in[i] = (const float*)d_in[i];
    a.out = (float*)d_out; a.ws = (unsigned char*)d_ws; a.ph_lo = 0; a.ph_hi = 16;
    hipLaunchKernelGGL(mega, dim3(g_grid), dim3(NTHREADS), LDS_BYTES, stream, a);
}
```

```cpp
#include <hip/hip_runtime.h>
#include <cstdio>
#include <cstdint>
#include <cmath>

constexpr int NT = 32768, DM = 1024, SEQ = 8192, NBATCH = 4;
constexpr int EVEN_IN = 3072, ODD_IN = 416, ODD_INP = 512;
constexpr int NEXP = 32, FF = 256;
constexpr float NORM_EPS = 1e-6f;
constexpr float LOG2E = 1.4426950408889634f;
constexpr float C2_64 = 0.125f * LOG2E;
constexpr float C2_96 = 0.10206207261596575f * LOG2E;
constexpr float LAM_INIT = 0.2f;

typedef unsigned short bf16_t;
typedef float f32x4 __attribute__((ext_vector_type(4)));
typedef float f32x2 __attribute__((ext_vector_type(2)));
typedef unsigned u32x4 __attribute__((ext_vector_type(4)));
typedef unsigned u32x2 __attribute__((ext_vector_type(2)));
typedef int i32x4 __attribute__((ext_vector_type(4)));

constexpr size_t MiB = 1u << 20;
constexpr size_t WS_CTL = 0, CTL_BYTES = 1 * MiB;
constexpr size_t CTL_CNT0 = 4096, CTL_CNT1 = 4096 + 256;
constexpr size_t CTL_Q2 = 8192, CTL_Q10 = 8192 + 2048;
constexpr size_t CTL_KMEAN = 512 * 1024;
constexpr size_t WS_W_IN0T = 1 * MiB;
constexpr size_t WS_W_OUT0T = WS_W_IN0T + 6 * MiB;
constexpr size_t WS_W_IN1T = WS_W_OUT0T + 2 * MiB;
constexpr size_t WS_W_QUPT = WS_W_IN1T + 1 * MiB;
constexpr size_t WS_W_KVUPT = WS_W_QUPT + 1 * MiB;
constexpr size_t WS_W_OUT1T = WS_W_KVUPT + 1 * MiB;
constexpr size_t WS_W_UPT = WS_W_OUT1T + 2 * MiB;
constexpr size_t WS_W_DNT = WS_W_UPT + 64 * MiB;
constexpr size_t WS_W_RT = WS_W_DNT + 32 * MiB;
constexpr size_t WS_CS64 = WS_W_RT + 1 * MiB;
constexpr size_t WS_CS32 = WS_CS64 + 2 * MiB;
constexpr size_t WS_RSTD = WS_CS32 + 1 * MiB;
constexpr size_t WS_GW = WS_RSTD + 512 * 1024;
constexpr size_t WS_LIST = WS_GW + 512 * 1024;
constexpr size_t WS_XB = WS_LIST + 4 * MiB;
constexpr size_t WS_OMIX = WS_XB + 64 * MiB;
constexpr size_t WS_BIG = WS_OMIX + 64 * MiB;
constexpr size_t WS_QKV0 = WS_BIG;
constexpr size_t WS_Y = WS_BIG;
constexpr size_t WS_H = WS_BIG + 128 * MiB;
constexpr size_t WS_Q1 = WS_BIG;
constexpr size_t WS_KN1 = WS_BIG + 96 * MiB;
constexpr size_t WS_V1 = WS_BIG + 160 * MiB;
constexpr size_t WS_Z1 = WS_BIG + 224 * MiB;
constexpr size_t WS_KR = WS_BIG + 256 * MiB;
constexpr size_t WS_END = WS_BIG + 258 * MiB;
static_assert(WS_END <= 512 * MiB, "workspace map exceeds 512 MiB");
constexpr size_t WS_PO0 = WS_XB, WS_PO1 = WS_XB + 32 * MiB, WS_PO2 = WS_BIG + 192 * MiB;
constexpr size_t WS_PML = WS_BIG + 224 * MiB;
constexpr size_t WS_LST = WS_BIG + 232 * MiB;
__host__ __device__ __forceinline__ size_t lst_base(int l) { const int bh = l >> 5, j = l & 31; return (size_t)bh * 126976 + (size_t)256 * (31 * j - (j * (j - 1)) / 2); }
constexpr size_t CTL_LCNT = 32768, CTL_Q2B = 36864;
constexpr size_t WS_SCR = WS_BIG + 192 * MiB;

__host__ __device__ __forceinline__ unsigned f2bf(float f) { unsigned u = __builtin_bit_cast(unsigned, f); return (u + 0x7fffu + ((u >> 16) & 1u)) >> 16; }
__host__ __device__ __forceinline__ float bf2f(unsigned short h) { return __builtin_bit_cast(float, (unsigned)h << 16); }
__device__ __forceinline__ float wave_sum(float v) {
#pragma unroll
    for (int o = 1; o < 64; o <<= 1) v += __shfl_xor(v, o);
    return v;
}
__host__ __device__ __forceinline__ int perm8(int p) { return (p & ~31) | (((p >> 2) & 3) << 3) | (((p >> 4) & 1) << 2) | (p & 3); }
__host__ __device__ __forceinline__ int win0_truecol(int p) {
    { const int un = p >> 8; if (un == 4 || un == 5 || un >= 10) return perm8(p); }
    const int u = p >> 8, q = p & 255, bj = q >> 7, wc = (q >> 5) & 3, n = (q >> 4) & 1, lo = q & 15;
    return (u << 8) + 64 * (2 * bj + (wc >> 1)) + 32 * n + 16 * (wc & 1) + lo;
}
__host__ __device__ __forceinline__ int qup_truecol(int p) {
    if (p < 1024) { const int c = perm8(p); return (c >> 6) * 96 + (c & 63); }
    const int q = p - 1024; return (q >> 5) * 96 + 64 + (q & 31);
}

__device__ __forceinline__ void sincos_d(double x, double& s, double& c) {
    const double k = rint(x * 0.63661977236758134308);
    double r = fma(-k, 1.57079632679489655800e+00, x); r = fma(-k, 6.12323399573676603587e-17, r);
    const double r2 = r * r;
    double sp = r2 * (-1.0 / 6227020800.0) + (1.0 / 39916800.0); sp = sp * r2 - (1.0 / 362880.0); sp = sp * r2 + (1.0 / 5040.0); sp = sp * r2 - (1.0 / 120.0); sp = sp * r2 + (1.0 / 6.0);
    const double sr = r - r * r2 * sp;
    double cp = r2 * (1.0 / 479001600.0) - (1.0 / 3628800.0); cp = cp * r2 + (1.0 / 40320.0); cp = cp * r2 - (1.0 / 720.0); cp = cp * r2 + (1.0 / 24.0); cp = cp * r2 - 0.5;
    const double cr = 1.0 + r2 * cp;
    const long long ki = (long long)k; const int q = (int)(ki & 3);
    s = (q == 0) ? sr : (q == 1) ? cr : (q == 2) ? -sr : -cr;
    c = (q == 0) ? cr : (q == 1) ? -sr : (q == 2) ? -cr : sr;
}

#define LAS __attribute__((address_space(3)))
#define GAS __attribute__((address_space(1)))
typedef short bf16x8 __attribute__((ext_vector_type(8)));
typedef float f32x16 __attribute__((ext_vector_type(16)));
constexpr int NWAVES = 8, NTHREADS = 512;
constexpr int LDS_RING = 131072;
constexpr int LDS_MISC = LDS_RING;
constexpr int LM_BAR = 0;
constexpr int LM_CNT = 256;
constexpr int LM_PBASE = 512;
constexpr int LM_STAT = 1024;
constexpr int LM_ROWOFF = 5120;
constexpr int LM_ATTN = 13312;
constexpr int LM_QSLOT = 128;
constexpr int LM_LCNT = 768;
constexpr int LDS_BYTES = 147456;

extern __shared__ __attribute__((aligned(16))) unsigned char lds_raw[];
constexpr int LM_WTAB = 15360;
__device__ __forceinline__ int hw_wave_slot() { return (int)(__builtin_amdgcn_s_getreg((5 << 11) | 4) & 63u); }
__device__ __forceinline__ int my_tid() {
    const int wid = __builtin_amdgcn_readfirstlane(((LAS const volatile int*)((LAS unsigned char*)lds_raw + LDS_MISC + LM_WTAB))[hw_wave_slot()]);
    return wid * 64 + (int)__builtin_amdgcn_mbcnt_hi(~0u, __builtin_amdgcn_mbcnt_lo(~0u, 0u));
}

__device__ __forceinline__ unsigned cvt_pk_bf16(float lo, float hi) { typedef __bf16 bf16x2_t __attribute__((ext_vector_type(2))); f32x2 v = {lo, hi}; bf16x2_t b = __builtin_convertvector(v, bf16x2_t); return __builtin_bit_cast(unsigned, b); }

namespace pg8 {
constexpr int BM = 256, BK = 64, HALF = 128, HTB = HALF * BK * 2, STAGE_BYTES = 8 * HTB, NXCD = 8, WGM = 8;
__host__ __device__ __forceinline__ int lds_byte(int r, int c) { const int st = (r >> 4) * 2 + (c >> 5), rr = r & 15, cc = c & 31, ob = rr * 64 + cc * 2; return st * 1024 + (ob ^ (((ob >> 9) & 1) << 5)); }
__host__ __device__ __forceinline__ void stage_rc(int b, int& R, int& C) { const int st = b / 1024, sb = b % 1024, swz = sb ^ (((sb >> 9) & 1) << 5); R = (st >> 1) * 16 + swz / 64; C = (st & 1) * 32 + (swz % 64) / 2; }

struct Unit { int pm, pn, e, panel, nrows, slot; };

struct DenseSched {
    const char* A; const char* Bt; unsigned lda_b; unsigned K2;
    int nM, nN, nwg, G, c;
    __device__ void init(const void* A_, unsigned lda_bytes, const void* Bt_, int M, int N, int K, int G_, int c_) { A = (const char*)A_; Bt = (const char*)Bt_; lda_b = lda_bytes; K2 = (unsigned)K * 2u; nM = M / BM; nN = N / BM; nwg = nM * nN; G = G_; c = c_; }
    __device__ __forceinline__ bool next(int i, Unit& u) const {
        const long L = (long)i * G + c; if (L >= nwg) return false;
        int wgid = (int)L; { const int q = nwg / NXCD, r = nwg % NXCD, xcd = wgid % NXCD, off = wgid / NXCD; wgid = (xcd < r ? xcd * (q + 1) : r * (q + 1) + (xcd - r) * q) + off; }
        const int nig = WGM * nN, gid = wgid / nig, fm = gid * WGM, gsz = (nM - fm) < WGM ? (nM - fm) : WGM;
        u.pm = fm + ((wgid % nig) % gsz); u.pn = (wgid % nig) / gsz; u.e = 0; u.panel = 0; u.nrows = 256; u.slot = 0; return true;
    }
    static constexpr bool GATHER = false;
    __device__ __forceinline__ const char* abase(const Unit& u) const { return A + (size_t)u.pm * BM * lda_b; }
    __device__ __forceinline__ unsigned lda() const { return lda_b; }
    __device__ __forceinline__ unsigned arow(const Unit&, int) const { return 0u; }
    __device__ __forceinline__ const char* bbase(const Unit& u) const { return Bt + (size_t)u.pn * BM * K2; }
};

template <class Epi, class Sched, bool ALIGN_EPI, bool SP2>
__device__ __forceinline__ void gemm_phase(LAS unsigned char* lds, const int K, const Sched& S, const Epi& E) {
    int tid_ = my_tid(); asm volatile("" : "+v"(tid_));
    const int tid = tid_, wid = __builtin_amdgcn_readfirstlane(tid >> 6), lane = tid & 63, wr = wid >> 2, wc = wid & 3, fr = lane & 15, fq = lane >> 4;
    int nt = K / BK; asm volatile("" : "+s"(nt));
    int sR[2], sC[2]; unsigned voffB[2], voffA[2];
#pragma unroll
    for (int i = 0; i < 2; ++i) { stage_rc(tid * 16 + i * 8192, sR[i], sC[i]); voffB[i] = (unsigned)(sR[i] * K + sC[i]) * 2u; voffA[i] = Sched::GATHER ? (unsigned)sC[i] * 2u : (unsigned)sR[i] * S.lda() + (unsigned)sC[i] * 2u; }
    const size_t kstep = (size_t)(BK * 2);
    const size_t hstepB = (size_t)HALF * K * 2;
    const size_t hstepA = Sched::GATHER ? 0 : (size_t)HALF * S.lda();
    const unsigned ldsw = (unsigned)wid * 1024u;
    const int aoff = lds_byte(wr * 64 + fr, fq * 8), boff = lds_byte(wc * 32 + fr, fq * 8);
#define PG8_SA(b, h) (((b) * 2 + (h)) * HTB)
#define PG8_SB(b, h) ((4 + (b) * 2 + (h)) * HTB)
#define PG8_STAGE(bufoff, gbase, voff) do { _Pragma("unroll") for (int _i = 0; _i < 2; ++_i) \
        __builtin_amdgcn_global_load_lds((const GAS unsigned*)((const char*)(gbase) + (voff)[_i]), (LAS unsigned*)(lds + (bufoff) + ldsw + _i * 8192), 16, 0, 0); } while (0)
#define PG8_STAGE_A(bufoff, gbase, h, VV) do { if constexpr (Sched::GATHER) { PG8_STAGE(bufoff, gbase, (VV)[h]); } else { PG8_STAGE(bufoff, (gbase) + (h) * hstepA, voffA); } } while (0)
#define PG8_LDA(dst, b, h) do { _Pragma("unroll") for (int m = 0; m < 4; ++m) _Pragma("unroll") for (int k = 0; k < 2; ++k) dst[m][k] = *(const LAS bf16x8*)(lds + PG8_SA(b, h) + aoff + m * 2048 + k * 1024); } while (0)
#define PG8_LDB(dst, b, h) do { _Pragma("unroll") for (int n = 0; n < 2; ++n) _Pragma("unroll") for (int k = 0; k < 2; ++k) dst[n][k] = *(const LAS bf16x8*)(lds + PG8_SB(b, h) + boff + n * 2048 + k * 1024); } while (0)
#define PG8_MMA(ai, bj, At, Bt) do { __builtin_amdgcn_s_setprio(1); _Pragma("unroll") for (int m = 0; m < 4; ++m) _Pragma("unroll") for (int n = 0; n < 2; ++n) _Pragma("unroll") for (int k = 0; k < 2; ++k) \
        acc[ai][bj][m][n] = __builtin_amdgcn_mfma_f32_16x16x32_bf16(Bt[n][k], At[m][k], acc[ai][bj][m][n], 0, 0, 0); __builtin_amdgcn_s_setprio(0); } while (0)
#define PG8_WAIT_V(n) asm volatile("s_waitcnt vmcnt(" #n ")" ::: "memory")
#define PG8_WAIT_L(n) asm volatile("s_waitcnt lgkmcnt(" #n ")" ::: "memory")
#define PG8_BAR __builtin_amdgcn_s_barrier()
#define PG8_SCHED __builtin_amdgcn_sched_barrier(0)
#define PG8_VOFF(dst, u) do { if constexpr (Sched::GATHER) { _Pragma("unroll") for (int _h = 0; _h < 2; ++_h) _Pragma("unroll") for (int _i = 0; _i < 2; ++_i) dst[_h][_i] = S.arow(u, _h * HALF + sR[_i]) + voffA[_i]; } } while (0)
    Unit cur, nxt; int ui = 0;
    if (!S.next(0, cur)) return;
    f32x4 acc[2][2][4][2];
#pragma unroll
    for (int a = 0; a < 2; ++a)
#pragma unroll
        for (int b = 0; b < 2; ++b)
#pragma unroll
            for (int m = 0; m < 4; ++m)
#pragma unroll
                for (int n = 0; n < 2; ++n) acc[a][b][m][n] = (f32x4){0.f, 0.f, 0.f, 0.f};
    bf16x8 At[4][2], B0[2][2], B1[2][2];
    unsigned cv[2][2] = {{0u, 0u}, {0u, 0u}};
    PG8_VOFF(cv, cur);
    const char* cA = S.abase(cur); const char* cB = S.bbase(cur);
    if constexpr (SP2) {
        PG8_STAGE(PG8_SB(0, 0), cB, voffB); PG8_STAGE(PG8_SB(0, 1), cB + hstepB, voffB); PG8_STAGE_A(PG8_SA(0, 0), cA, 0, cv); PG8_STAGE_A(PG8_SA(0, 1), cA, 1, cv);
        if (wr == 1) PG8_BAR;
        PG8_WAIT_V(2); PG8_BAR;
        PG8_STAGE(PG8_SB(1, 0), cB + kstep, voffB); PG8_STAGE_A(PG8_SA(1, 0), cA + kstep, 0, cv); PG8_STAGE(PG8_SB(1, 1), cB + hstepB + kstep, voffB);
        PG8_WAIT_V(6); PG8_BAR;
    } else {
        PG8_STAGE(PG8_SB(0, 0), cB, voffB); PG8_STAGE_A(PG8_SA(0, 0), cA, 0, cv); PG8_STAGE(PG8_SB(0, 1), cB + hstepB, voffB); PG8_STAGE_A(PG8_SA(0, 1), cA, 1, cv);
        if (wr == 1) PG8_BAR;
        PG8_WAIT_V(4); PG8_BAR;
        PG8_STAGE(PG8_SB(1, 0), cB + kstep, voffB); PG8_STAGE_A(PG8_SA(1, 0), cA + kstep, 0, cv); PG8_STAGE(PG8_SB(1, 1), cB + hstepB + kstep, voffB);
        PG8_WAIT_V(6); PG8_BAR;
    }
    for (;;) {
        const bool has_next = S.next(ui + 1, nxt);
        const char* nA = has_next ? S.abase(nxt) : cA; const char* nB = has_next ? S.bbase(nxt) : cB;
        for (int t = 0; t < nt; t += 2) {
            const bool last = (t == nt - 2);
            const char* a1 = cA + (size_t)(t + 1) * kstep;
            const char* a2 = last ? nA : cA + (size_t)(t + 2) * kstep; const char* b2 = last ? nB : cB + (size_t)(t + 2) * kstep;
            const char* a3 = a2 + kstep; const char* b3 = b2 + kstep;
            if constexpr (SP2) {
            PG8_LDB(B0, 0, 0); PG8_LDB(B1, 0, 1); PG8_SCHED; PG8_LDA(At, 0, 0); PG8_STAGE_A(PG8_SA(1, 1), a1, 1, cv);
            if (last && has_next) { PG8_VOFF(cv, nxt); }
            PG8_WAIT_V(8); PG8_WAIT_L(0); PG8_BAR; PG8_MMA(0, 0, At, B0); PG8_MMA(0, 1, At, B1); PG8_BAR; PG8_SCHED;
            PG8_LDA(At, 0, 1); PG8_STAGE(PG8_SB(0, 0), b2, voffB); PG8_STAGE(PG8_SB(0, 1), b2 + hstepB, voffB); PG8_STAGE_A(PG8_SA(0, 0), a2, 0, cv);
            PG8_WAIT_V(8); PG8_WAIT_L(0); PG8_BAR; PG8_MMA(1, 0, At, B0); PG8_MMA(1, 1, At, B1); PG8_BAR; PG8_SCHED;
            PG8_LDB(B0, 1, 0); PG8_LDB(B1, 1, 1); PG8_SCHED; PG8_LDA(At, 1, 0); PG8_STAGE_A(PG8_SA(0, 1), a2, 1, cv);
            PG8_WAIT_V(8); PG8_WAIT_L(0); PG8_BAR; PG8_MMA(0, 0, At, B0); PG8_MMA(0, 1, At, B1); PG8_BAR; PG8_SCHED;
            PG8_LDA(At, 1, 1); PG8_STAGE(PG8_SB(1, 0), b3, voffB); PG8_STAGE(PG8_SB(1, 1), b3 + hstepB, voffB); PG8_STAGE_A(PG8_SA(1, 0), a3, 0, cv);
            PG8_WAIT_V(8); PG8_WAIT_L(0); PG8_BAR; PG8_MMA(1, 0, At, B0); PG8_MMA(1, 1, At, B1); PG8_BAR; PG8_SCHED;
            } else {
            PG8_LDB(B0, 0, 0); PG8_SCHED; PG8_LDA(At, 0, 0); PG8_STAGE_A(PG8_SA(1, 1), a1, 1, cv);
            if (last && has_next) { PG8_VOFF(cv, nxt); }
            PG8_WAIT_L(8); PG8_BAR; PG8_WAIT_L(0); PG8_MMA(0, 0, At, B0); PG8_BAR; PG8_SCHED;
            PG8_LDB(B1, 0, 1); PG8_STAGE(PG8_SB(0, 0), b2, voffB);
            PG8_BAR; PG8_WAIT_L(0); PG8_MMA(0, 1, At, B1); PG8_BAR;
            PG8_LDA(At, 0, 1); PG8_STAGE_A(PG8_SA(0, 0), a2, 0, cv);
            PG8_BAR; PG8_WAIT_L(0); PG8_MMA(1, 0, At, B0); PG8_BAR; PG8_SCHED;
            PG8_STAGE(PG8_SB(0, 1), b2 + hstepB, voffB);
            PG8_WAIT_V(6); PG8_BAR; PG8_MMA(1, 1, At, B1); PG8_BAR;
            PG8_LDB(B0, 1, 0); PG8_SCHED; PG8_LDA(At, 1, 0); PG8_STAGE_A(PG8_SA(0, 1), a2, 1, cv);
            PG8_WAIT_L(8); PG8_BAR; PG8_WAIT_L(0); PG8_MMA(0, 0, At, B0); PG8_BAR; PG8_SCHED;
            PG8_LDB(B1, 1, 1); PG8_STAGE(PG8_SB(1, 0), b3, voffB);
            PG8_BAR; PG8_WAIT_L(0); PG8_MMA(0, 1, At, B1); PG8_BAR;
            PG8_LDA(At, 1, 1); PG8_STAGE_A(PG8_SA(1, 0), a3, 0, cv);
            PG8_BAR; PG8_WAIT_L(0); PG8_MMA(1, 0, At, B0); PG8_BAR; PG8_SCHED;
            PG8_STAGE(PG8_SB(1, 1), b3 + hstepB, voffB);
            PG8_WAIT_V(6); PG8_BAR; PG8_MMA(1, 1, At, B1); PG8_BAR;
            }
        }
        if constexpr (ALIGN_EPI) { if (wr == 0) PG8_BAR; }
        E(acc, cur, wr, wc, fr, fq);
        if (!has_next) break;
#pragma unroll
        for (int a = 0; a < 2; ++a)
#pragma unroll
            for (int b = 0; b < 2; ++b)
#pragma unroll
                for (int m = 0; m < 4; ++m)
#pragma unroll
                    for (int n = 0; n < 2; ++n) acc[a][b][m][n] = (f32x4){0.f, 0.f, 0.f, 0.f};
        cur = nxt; cA = nA; cB = nB; ++ui;
        if constexpr (ALIGN_EPI) { if (wr == 1) PG8_BAR; }
    }
    PG8_WAIT_V(0);
    if constexpr (!ALIGN_EPI) { if (wr == 0) PG8_BAR; }
    PG8_BAR;
#undef PG8_SA
#undef PG8_SB
#undef PG8_STAGE
#undef PG8_STAGE_A
#undef PG8_LDA
#undef PG8_LDB
#undef PG8_MMA
#undef PG8_WAIT_V
#undef PG8_WAIT_L
#undef PG8_BAR
#undef PG8_SCHED
#undef PG8_VOFF
}

typedef const f32x4 (&AccRef)[2][2][4][2];

struct EpiWin0 {
    const float* rstd; const f32x2* cs64; bf16_t* qkv; float* kmean;
    __device__ __forceinline__ void operator()(AccRef acc, const Unit& u, int wr, int wc, int fr, int fq) const {
        const int pn = u.pn; const bool rope = (pn < 4) || (pn >= 6 && pn < 10); const bool qs = (pn < 2) || (pn == 6) || (pn == 7); const bool km = (pn == 2) || (pn == 3); const bool vsec = (pn == 4) || (pn == 5) || (pn >= 10);
        const int dlo = 16 * (wc & 1) + 4 * fq;
        f32x4 ks[2][2];
#pragma unroll
        for (int bj = 0; bj < 2; ++bj) { ks[bj][0] = (f32x4){0.f, 0.f, 0.f, 0.f}; ks[bj][1] = (f32x4){0.f, 0.f, 0.f, 0.f}; }
#pragma unroll
        for (int ai = 0; ai < 2; ++ai)
#pragma unroll
            for (int m = 0; m < 4; ++m) {
                const int r = u.pm * BM + ai * HALF + wr * 64 + m * 16 + fr, t = r & (SEQ - 1);
                const float rs = rstd[r];
                f32x4 c4 = {1.f, 1.f, 1.f, 1.f}, s4 = {0.f, 0.f, 0.f, 0.f};
                if (rope) { const f32x4 a = *(const f32x4*)(cs64 + t * 32 + dlo), b = *(const f32x4*)(cs64 + t * 32 + dlo + 2); c4 = (f32x4){a.x, a.z, b.x, b.z}; s4 = (f32x4){a.y, a.w, b.y, b.w}; }
                const float sc = qs ? rs * C2_64 : rs;
#pragma unroll
                for (int bj = 0; bj < 2; ++bj) {
                    const f32x4 x1 = acc[ai][bj][m][0] * sc, x2 = acc[ai][bj][m][1] * sc;
                    const f32x4 y1 = x1 * c4 - x2 * s4, y2 = x1 * s4 + x2 * c4;
                    if (km) { ks[bj][0] += y1; ks[bj][1] += y2; }
                    u32x2 w1, w2; w1.x = cvt_pk_bf16(y1.x, y1.y); w1.y = cvt_pk_bf16(y1.z, y1.w); w2.x = cvt_pk_bf16(y2.x, y2.y); w2.y = cvt_pk_bf16(y2.z, y2.w);
                    if (vsec) { *(u32x4*)(qkv + (size_t)r * EVEN_IN + pn * BM + bj * HALF + wc * 32 + 8 * fq) = (u32x4){w1.x, w1.y, w2.x, w2.y}; }
                    else { bf16_t* dst = qkv + (size_t)r * EVEN_IN + pn * BM + 64 * (2 * bj + (wc >> 1)) + dlo; *(u32x2*)dst = w1; *(u32x2*)(dst + 32) = w2; }
                }
            }
        if (km) {
            const int b = u.pm >> 5, blk = u.pm & 31;
#pragma unroll
            for (int bj = 0; bj < 2; ++bj)
#pragma unroll
                for (int n = 0; n < 2; ++n) { f32x4 v = ks[bj][n];
#pragma unroll
                    for (int o = 1; o < 16; o <<= 1) { v.x += __shfl_xor(v.x, o); v.y += __shfl_xor(v.y, o); v.z += __shfl_xor(v.z, o); v.w += __shfl_xor(v.w, o); }
                    if (fr == 0) { const int h = (pn - 2) * 4 + 2 * bj + (wc >> 1); float* dst = kmean + ((size_t)(b * 8 + h) * 32 + blk) * 64 + 32 * n + dlo;
                        atomicAdd(dst + 0, v.x * (1.0f / 256.0f)); atomicAdd(dst + 1, v.y * (1.0f / 256.0f)); atomicAdd(dst + 2, v.z * (1.0f / 256.0f)); atomicAdd(dst + 3, v.w * (1.0f / 256.0f)); } }
        }
    }
};
template <bool BF> struct EpiWout {
    const float* base_f; bf16_t* xb;
    __device__ __forceinline__ void operator()(AccRef acc, const Unit& u, int wr, int wc, int fr, int fq) const {
#pragma unroll
        for (int ai = 0; ai < 2; ++ai)
#pragma unroll
            for (int m = 0; m < 4; ++m) {
                const size_t off = (size_t)(u.pm * BM + ai * HALF + wr * 64 + m * 16 + fr) * DM + u.pn * BM + wc * 32 + 8 * fq;
#pragma unroll
                for (int bj = 0; bj < 2; ++bj) { const size_t o = off + bj * HALF; f32x4 v0, v1;
                    if (BF) { const u32x4 r = *(const u32x4*)(xb + o); v0 = (f32x4){bf2f((unsigned short)(r.x & 0xffff)), bf2f((unsigned short)(r.x >> 16)), bf2f((unsigned short)(r.y & 0xffff)), bf2f((unsigned short)(r.y >> 16))};
                        v1 = (f32x4){bf2f((unsigned short)(r.z & 0xffff)), bf2f((unsigned short)(r.z >> 16)), bf2f((unsigned short)(r.w & 0xffff)), bf2f((unsigned short)(r.w >> 16))}; }
                    else { v0 = __builtin_nontemporal_load((const f32x4*)(base_f + o)); v1 = __builtin_nontemporal_load((const f32x4*)(base_f + o + 4)); }
                    v0 += acc[ai][bj][m][0]; v1 += acc[ai][bj][m][1];
                    *(u32x4*)(xb + o) = (u32x4){cvt_pk_bf16(v0.x, v0.y), cvt_pk_bf16(v0.z, v0.w), cvt_pk_bf16(v1.x, v1.y), cvt_pk_bf16(v1.z, v1.w)}; }
                if (BF ? (m == 3) : (m & 1)) asm volatile("" ::: "memory");
            }
    }
};
struct EpiWin1 {
    const float* rstd; const f32x2* cs32; bf16_t* z1; bf16_t* kr; LAS float* stat;
    __device__ __forceinline__ void operator()(AccRef acc, const Unit& u, int wr, int wc, int fr, int fq) const {
        const int pn = u.pn; const int nbj = (pn == 0) ? 2 : 1;
#pragma unroll
        for (int ai = 0; ai < 2; ++ai)
#pragma unroll
            for (int m = 0; m < 4; ++m) {
                const int rl = ai * HALF + wr * 64 + m * 16 + fr; const float rs = rstd[u.pm * BM + rl];
                float s = 0.f;
#pragma unroll
                for (int bj = 0; bj < 2; ++bj) if (bj < nbj)
#pragma unroll
                    for (int n = 0; n < 2; ++n) { const f32x4 x = acc[ai][bj][m][n] * rs; s += (x.x * x.x + x.y * x.y) + (x.z * x.z + x.w * x.w); }
                s += __shfl_xor(s, 16); s += __shfl_xor(s, 32);
                if (fq == 0) stat[rl * 4 + wc] = s;
            }
        asm volatile("s_waitcnt lgkmcnt(0)" ::: "memory"); __builtin_amdgcn_s_barrier(); asm volatile("" ::: "memory");
#pragma unroll
        for (int ai = 0; ai < 2; ++ai)
#pragma unroll
            for (int m = 0; m < 4; ++m) {
                const int rl = ai * HALF + wr * 64 + m * 16 + fr, r = u.pm * BM + rl, t = r & (SEQ - 1); const float rs = rstd[r];
                const f32x4 st = *(const LAS f32x4*)(stat + rl * 4);
                const float ssq = (st.x + st.y) + (st.z + st.w);
                const float rn = rs / sqrtf(ssq * (pn == 0 ? (1.0f / 256.0f) : (1.0f / 128.0f)) + NORM_EPS);
#pragma unroll
                for (int bj = 0; bj < 2; ++bj) if (bj < nbj) { const f32x4 v0 = acc[ai][bj][m][0] * rn, v1 = acc[ai][bj][m][1] * rn;
                        *(u32x4*)(z1 + (size_t)r * ODD_INP + pn * BM + bj * HALF + wc * 32 + 8 * fq) = (u32x4){cvt_pk_bf16(v0.x, v0.y), cvt_pk_bf16(v0.z, v0.w), cvt_pk_bf16(v1.x, v1.y), cvt_pk_bf16(v1.z, v1.w)}; }
                if (pn == 1 && wc == 0) {
                    const f32x4 a = *(const f32x4*)(cs32 + t * 16 + 4 * fq), b = *(const f32x4*)(cs32 + t * 16 + 4 * fq + 2);
                    const f32x4 c4 = {a.x, a.z, b.x, b.z}, s4 = {a.y, a.w, b.y, b.w};
                    const f32x4 x1 = acc[ai][1][m][0] * rs, x2 = acc[ai][1][m][1] * rs, y1 = x1 * c4 - x2 * s4, y2 = x1 * s4 + x2 * c4;
                    u32x2 w1, w2; w1.x = cvt_pk_bf16(y1.x, y1.y); w1.y = cvt_pk_bf16(y1.z, y1.w); w2.x = cvt_pk_bf16(y2.x, y2.y); w2.y = cvt_pk_bf16(y2.z, y2.w);
                    *(u32x2*)(kr + (size_t)r * 32 + 4 * fq) = w1; *(u32x2*)(kr + (size_t)r * 32 + 16 + 4 * fq) = w2;
                }
            }
    }
};
struct EpiQup {
    const f32x2* cs32; bf16_t* q1;
    __device__ __forceinline__ void operator()(AccRef acc, const Unit& u, int wr, int wc, int fr, int fq) const {
        const int pn = u.pn;
#pragma unroll
        for (int ai = 0; ai < 2; ++ai)
#pragma unroll
            for (int m = 0; m < 4; ++m) {
                const int r = u.pm * BM + ai * HALF + wr * 64 + m * 16 + fr, t = r & (SEQ - 1);
                bf16_t* row = q1 + (size_t)r * 1536;
                if (pn < 4) {
#pragma unroll
                    for (int bj = 0; bj < 2; ++bj) { const f32x4 v0 = acc[ai][bj][m][0] * C2_96, v1 = acc[ai][bj][m][1] * C2_96;
                            const int head = pn * 4 + bj * 2 + (wc >> 1), d = 32 * (wc & 1) + 8 * fq;
                            *(u32x4*)(row + head * 96 + d) = (u32x4){cvt_pk_bf16(v0.x, v0.y), cvt_pk_bf16(v0.z, v0.w), cvt_pk_bf16(v1.x, v1.y), cvt_pk_bf16(v1.z, v1.w)}; }
                } else {
                    const f32x4 a = *(const f32x4*)(cs32 + t * 16 + 4 * fq), b = *(const f32x4*)(cs32 + t * 16 + 4 * fq + 2);
                    const f32x4 c4 = {a.x, a.z, b.x, b.z}, s4 = {a.y, a.w, b.y, b.w};
#pragma unroll
                    for (int bj = 0; bj < 2; ++bj) { const f32x4 x1 = acc[ai][bj][m][0] * C2_96, x2 = acc[ai][bj][m][1] * C2_96, y1 = x1 * c4 - x2 * s4, y2 = x1 * s4 + x2 * c4;
                        u32x2 w1, w2; w1.x = cvt_pk_bf16(y1.x, y1.y); w1.y = cvt_pk_bf16(y1.z, y1.w); w2.x = cvt_pk_bf16(y2.x, y2.y); w2.y = cvt_pk_bf16(y2.z, y2.w);
                        const int head = (pn - 4) * 8 + bj * 4 + wc; *(u32x2*)(row + head * 96 + 64 + 4 * fq) = w1; *(u32x2*)(row + head * 96 + 80 + 4 * fq) = w2; }
                }
            }
    }
};
struct EpiKvup {
    bf16_t* kn1; bf16_t* v1;
    __device__ __forceinline__ void operator()(AccRef acc, const Unit& u, int wr, int wc, int fr, int fq) const {
#pragma unroll
        for (int ai = 0; ai < 2; ++ai)
#pragma unroll
            for (int m = 0; m < 4; ++m) {
                const size_t r = (size_t)(u.pm * BM + ai * HALF + wr * 64 + m * 16 + fr);
#pragma unroll
                for (int bj = 0; bj < 2; ++bj) { const f32x4 v0 = acc[ai][bj][m][0], vv = acc[ai][bj][m][1];
                        const int head = u.pn * 2 + bj, j = wc * 32 + 8 * fq;
                        bf16_t* dst = (wc < 2) ? (kn1 + r * 1024 + head * 64 + j) : (v1 + r * 1024 + head * 64 + (j - 64));
                        *(u32x4*)dst = (u32x4){cvt_pk_bf16(v0.x, v0.y), cvt_pk_bf16(v0.z, v0.w), cvt_pk_bf16(vv.x, vv.y), cvt_pk_bf16(vv.z, vv.w)}; }
            }
    }
};
}

__device__ __forceinline__ void moe_tables(LAS unsigned char* lds, const int* cntg) {
    LAS int* cnt = (LAS int*)(lds + LDS_MISC + LM_CNT); LAS int* pbase = (LAS int*)(lds + LDS_MISC + LM_PBASE);
    const int tid_m = my_tid();
    if (tid_m < 32) cnt[tid_m] = cntg[tid_m];
    __syncthreads();
    if (tid_m == 0) { int p = 0; for (int e = 0; e < 32; ++e) { pbase[e] = p; p += (cnt[e] + 255) >> 8; } pbase[32] = p; }
    __syncthreads();
}
template <bool GATHER_> struct MoeSched {
    static constexpr bool GATHER = GATHER_;
    const char* A; const char* Bt; LAS const int* cnt; LAS const int* pbase; LAS const unsigned* rowoff; unsigned lda_b, K2; int upp, G, c;
    __device__ __forceinline__ bool next(int i, pg8::Unit& u) const {
        int L = i * G + c; const int total = pbase[32] * upp; if (L >= total) return false;
        if ((G & 7) == 0 && (i + 1) * G <= total) L = i * G + (c & 7) * (G >> 3) + (c >> 3);
        const int pg = L / upp, sub = L - pg * upp; int e = 0;
        for (int j = 1; j < 32; ++j) e = (pbase[j] <= pg) ? j : e;
        u.e = e; u.panel = pg - pbase[e]; u.pm = pg; u.pn = sub; const int rem = cnt[e] - u.panel * 256; u.nrows = rem < 256 ? rem : 256; u.slot = i; return true;
    }
    __device__ __forceinline__ const char* abase(const pg8::Unit& u) const { return GATHER ? A : A + (size_t)u.pm * 256 * lda_b; }
    __device__ __forceinline__ unsigned lda() const { return lda_b; }
    __device__ __forceinline__ unsigned arow(const pg8::Unit& u, int R) const { return rowoff[(u.slot & 7) * 256 + R]; }
    __device__ __forceinline__ const char* bbase(const pg8::Unit& u) const { return Bt + ((size_t)u.e * upp + u.pn) * (256 * (size_t)K2); }
};
namespace pg8 {
struct EpiMoeUp {
    const int* list; const float* rstd; bf16_t* H;
    __device__ __forceinline__ void operator()(AccRef acc, const Unit& u, int wr, int wc, int fr, int fq) const {
#pragma unroll
        for (int ai = 0; ai < 2; ++ai)
#pragma unroll
            for (int m = 0; m < 4; ++m) {
                const int rl = ai * HALF + wr * 64 + m * 16 + fr; const bool valid = rl < u.nrows;
                const int tok = valid ? (list[(size_t)u.e * NT + u.panel * 256 + rl] >> 1) : 0; const float rs = rstd[tok];
                u32x4 w4;
#pragma unroll
                for (int n = 0; n < 2; ++n) { const f32x4 g = acc[ai][0][m][n] * rs, up = acc[ai][1][m][n] * rs; f32x4 h;
#pragma unroll
                    for (int j = 0; j < 4; ++j) h[j] = g[j] * up[j] * __builtin_amdgcn_rcpf(1.0f + __builtin_amdgcn_exp2f(-g[j] * LOG2E));
                    w4[2 * n] = cvt_pk_bf16(h.x, h.y); w4[2 * n + 1] = cvt_pk_bf16(h.z, h.w); }
                *(u32x4*)(H + (size_t)(u.pm * 256 + rl) * FF + u.pn * HALF + wc * 32 + 8 * fq) = w4;
            }
    }
};
struct EpiMoeDn {
    const int* list; const float* gw; bf16_t* Y;
    __device__ __forceinline__ void operator()(AccRef acc, const Unit& u, int wr, int wc, int fr, int fq) const {
#pragma unroll
        for (int ai = 0; ai < 2; ++ai)
#pragma unroll
            for (int m = 0; m < 4; ++m) {
                const int rl = ai * HALF + wr * 64 + m * 16 + fr;
                if (rl < u.nrows) {
                    const int entry = list[(size_t)u.e * NT + u.panel * 256 + rl]; const float w8 = gw[entry];
#pragma unroll
                    for (int bj = 0; bj < 2; ++bj) { const f32x4 v0 = acc[ai][bj][m][0] * w8, v1 = acc[ai][bj][m][1] * w8;
                            *(u32x4*)(Y + (size_t)entry * DM + u.pn * BM + bj * HALF + wc * 32 + 8 * fq) = (u32x4){cvt_pk_bf16(v0.x, v0.y), cvt_pk_bf16(v0.z, v0.w), cvt_pk_bf16(v1.x, v1.y), cvt_pk_bf16(v1.z, v1.w)}; }
                }
            }
    }
};
}

constexpr int RT_WSTRIDE = 2064;
__device__ __forceinline__ void route_phase(LAS unsigned char* lds, const bf16_t* xb, const bf16_t* wrt, const float* bg, const float* be, float* rstd_out, int* cntg, int* list, float* gw, int G, int c) {
    const int tid = my_tid(), wid = __builtin_amdgcn_readfirstlane(tid >> 6), lane = tid & 63;
    LAS int* lcnt = (LAS int*)(lds + LDS_MISC + LM_LCNT); LAS int* lbase = lcnt + 32;
    for (int i = tid; i < 48 * 128; i += NTHREADS) { const int r = i >> 7, ch = i & 127; *(LAS u32x4*)(lds + r * RT_WSTRIDE + ch * 16) = *(const u32x4*)(wrt + (size_t)r * DM + ch * 8); }
    if (tid < 32) lcnt[tid] = 0;
    __syncthreads();
    LAS float* lg = (LAS float*)(lds + 102400 + wid * 3072);
    for (int item = c; item < NT / 128; item += G) {
        const int tok0 = item * 128 + wid * 16;
        f32x4 acc[3] = {(f32x4){0.f, 0.f, 0.f, 0.f}, (f32x4){0.f, 0.f, 0.f, 0.f}, (f32x4){0.f, 0.f, 0.f, 0.f}};
        float ss = 0.f;
        const bf16_t* xr = xb + (size_t)(tok0 + (lane & 15)) * DM + 8 * (lane >> 4);
        const LAS unsigned char* wl = lds + (lane & 15) * RT_WSTRIDE + 16 * (lane >> 4);
#pragma unroll 4
        for (int s = 0; s < 32; ++s) {
            const bf16x8 a = *(const bf16x8*)(xr + 32 * s);
#pragma unroll
            for (int j = 0; j < 8; ++j) { const float f = bf2f((unsigned short)a[j]); ss = fmaf(f, f, ss); }
#pragma unroll
            for (int ct = 0; ct < 3; ++ct) { const bf16x8 b = *(const LAS bf16x8*)(wl + ct * 16 * RT_WSTRIDE + 64 * s); acc[ct] = __builtin_amdgcn_mfma_f32_16x16x32_bf16(a, b, acc[ct], 0, 0, 0); }
        }
        ss += __shfl_xor(ss, 16); ss += __shfl_xor(ss, 32);
        const float rs = 1.0f / sqrtf(ss * (1.0f / DM) + NORM_EPS);
#pragma unroll
        for (int ct = 0; ct < 3; ++ct)
#pragma unroll
            for (int j = 0; j < 4; ++j) lg[(4 * (lane >> 4) + j) * 48 + ct * 16 + (lane & 15)] = acc[ct][j];
        asm volatile("s_waitcnt lgkmcnt(0)" ::: "memory");
        int e0 = 0, e1 = 0, lp0 = 0, lp1 = 0; float w0 = 0.f, w1 = 0.f;
        if (lane < 16) {
            const LAS float* l = lg + lane * 48;
            float g4[4];
#pragma unroll
            for (int g = 0; g < 4; ++g) g4[g] = l[g] * rs + bg[g];
            int grp = 0; float gm = g4[0];
#pragma unroll
            for (int g = 1; g < 4; ++g) if (g4[g] > gm) { gm = g4[g]; grp = g; }
            float gs = 0.f;
#pragma unroll
            for (int g = 0; g < 4; ++g) gs += expf(g4[g] - gm);
            const float pgp = 1.0f / gs;
            float el[8];
#pragma unroll
            for (int i = 0; i < 8; ++i) el[i] = l[4 + grp * 8 + i] * rs + be[grp * 8 + i];
            int i0 = 0; float v0 = el[0];
#pragma unroll
            for (int i = 1; i < 8; ++i) if (el[i] > v0) { v0 = el[i]; i0 = i; }
            int i1 = -1; float v1 = -INFINITY;
#pragma unroll
            for (int i = 0; i < 8; ++i) if (i != i0 && el[i] > v1) { v1 = el[i]; i1 = i; }
            const float ex = expf(v1 - v0); w0 = pgp / (1.0f + ex); w1 = pgp * ex / (1.0f + ex);
            e0 = grp * 8 + i0; e1 = grp * 8 + i1;
            lp0 = __hip_atomic_fetch_add(lcnt + e0, 1, __ATOMIC_RELAXED, __HIP_MEMORY_SCOPE_WORKGROUP);
            lp1 = __hip_atomic_fetch_add(lcnt + e1, 1, __ATOMIC_RELAXED, __HIP_MEMORY_SCOPE_WORKGROUP);
            rstd_out[tok0 + lane] = rs; gw[(tok0 + lane) * 2] = w0; gw[(tok0 + lane) * 2 + 1] = w1;
        }
        __syncthreads();
        if (tid < 32) { const int n = lcnt[tid]; lbase[tid] = n ? atomicAdd(cntg + tid, n) : 0; }
        __syncthreads();
        if (lane < 16) { list[(size_t)e0 * NT + lbase[e0] + lp0] = (tok0 + lane) * 2; list[(size_t)e1 * NT + lbase[e1] + lp1] = (tok0 + lane) * 2 + 1; }
        __syncthreads();
        if (tid < 32) lcnt[tid] = 0;
        __syncthreads();
    }
}

namespace att {
typedef short s16x4 __attribute__((ext_vector_type(4)));
constexpr float THR = 8.0f;
__device__ __forceinline__ int crow(int r, int hi) { return (r & 3) + 8 * (r >> 2) + 4 * hi; }
__device__ __forceinline__ void glds16(const void* gsrc, unsigned lds_dst) { unsigned keep;
    asm volatile("s_mov_b32 %0, m0\n\ts_mov_b32 m0, %2\n\ts_nop 0\n\tglobal_load_lds_dwordx4 %1, off\n\ts_mov_b32 m0, %0" : "=&s"(keep) : "v"(gsrc), "s"(lds_dst) : "memory"); }
__device__ __forceinline__ void glds16s(const void* sbase, unsigned voff, unsigned lds_dst) { unsigned keep;
    asm volatile("s_mov_b32 %0, m0\n\ts_mov_b32 m0, %3\n\ts_nop 0\n\tglobal_load_lds_dwordx4 %1, %2\n\ts_mov_b32 m0, %0" : "=&s"(keep) : "v"(voff), "s"(sbase), "s"(lds_dst) : "memory"); }
__device__ __forceinline__ s16x4 vtr(LAS const unsigned char* p) { typedef short v4i16_t __attribute__((ext_vector_type(4))); return __builtin_bit_cast(s16x4, __builtin_amdgcn_ds_read_tr16_b64_v4i16((LAS v4i16_t*)p)); }
__device__ __forceinline__ float max3f(float a, float b, float c) { float r; asm("v_max3_f32 %0, %1, %2, %3" : "=v"(r) : "v"(a), "v"(b), "v"(c)); return r; }
__device__ __forceinline__ float max2f(float a, float b) { float r; asm("v_max_f32_e32 %0, %1, %2" : "=v"(r) : "v"(a), "v"(b)); return r; }
#ifndef ATT_SKIPDEAD
#define ATT_SKIPDEAD 1
#endif
#ifndef ATT_STAGGER
#define ATT_STAGGER 1
#endif
#define ATT_WAITBAR() asm volatile("s_waitcnt vmcnt(0) lgkmcnt(0)\n\ts_barrier" ::: "memory")

template <int DK, int DV, int MODE, bool LAG>
__device__ __forceinline__ bool attn_unit(LAS unsigned char* kv, LAS float* wsf, const bf16_t* qrow, const bf16_t* Kb, int ldk, const bf16_t* Krb, const bf16_t* Vb, int ldv,
                                          int qb, unsigned sel, f32x16 (&o)[DV / 32], float& m_out, float& l_out) {
    constexpr int KB = DK * 128, VB = DV * 128, NKC = DK / 8, NVP = DV / 8;
    constexpr bool NEGM = (DV <= 64) || LAG;
    int tid_o = my_tid(); asm volatile("" : "+v"(tid_o));
    const int tid = tid_o, lane = tid & 63, r32 = lane & 31, hi = lane >> 5; const int wid = __builtin_amdgcn_readfirstlane(tid >> 6);
    const unsigned lds0 = (unsigned)(uintptr_t)kv;
    bf16x8 qr[DK / 16];
#pragma unroll
    for (int d0 = 0; d0 < DK / 16; ++d0) qr[d0] = *(const bf16x8*)(qrow + d0 * 16 + hi * 8);
    const f32x16 zero16 = (f32x16){0.f, 0.f, 0.f, 0.f, 0.f, 0.f, 0.f, 0.f, 0.f, 0.f, 0.f, 0.f, 0.f, 0.f, 0.f, 0.f};
#pragma unroll
    for (int d = 0; d < DV / 32; ++d) o[d] = zero16;
    float m_run = 0.f, l_run = 0.f, lsa = 0.f, lsb = 0.f;
    f32x16 negm = zero16;
    const int NT = (MODE >= 2) ? 4 : 4 * (qb + 1);
    auto dma_k = [&](int kv0, int buf) {
        { const bf16_t* src = Kb + (size_t)kv0 * ldk + wid * 8; glds16s(src, (unsigned)(lane * ldk) * 2u, (unsigned)__builtin_amdgcn_readfirstlane(lds0 + buf * KB + wid * 1024)); }
        if (NKC == 12 && wid < 4) { const bf16_t* src = Krb + (size_t)kv0 * 32 + wid * 8; glds16s(src, (unsigned)lane * 64u, (unsigned)__builtin_amdgcn_readfirstlane(lds0 + buf * KB + (8 + wid) * 1024)); }
    };
    auto dma_v = [&](int kv0, int buf) {
#pragma unroll
        for (int pp = 0; pp < NVP / 8; ++pp) { const int pc = wid + 8 * pp, db = pc >> 2, rg = pc & 3;
            const bf16_t* src = Vb + (size_t)(kv0 + 16 * rg) * ldv + db * 32; glds16s(src, (unsigned)((lane >> 2) * ldv + (lane & 3) * 8) * 2u, (unsigned)__builtin_amdgcn_readfirstlane(lds0 + 2 * KB + buf * VB + pc * 1024)); }
    };
    auto tile_kv0 = [&](int i) -> int { if (MODE == 0) return 64 * i; if (MODE >= 2) return 256 * qb + 64 * i; return (i < 4) ? 256 * qb + 64 * i : 64 * (i - 4); };
    auto tile_jd = [&](int i) -> int { if (MODE == 0) return (i >= 4 * qb) ? i - 4 * qb : -1; if (MODE == 2) return i; if (MODE == 3) return -1; return (i < 4) ? i : -1; };
    auto qkt = [&](f32x16& p0, f32x16& p1, int buf, const f32x16& c0) {
        LAS const unsigned char* Kt = kv + buf * KB + hi * 1024 + r32 * 16;
#pragma unroll
        for (int d0 = 0; d0 < DK / 16; ++d0) {
            const bf16x8 k0 = *(LAS const bf16x8*)(Kt + d0 * 2048), k1 = *(LAS const bf16x8*)(Kt + d0 * 2048 + 512);
            if (d0 == 0) { p0 = __builtin_amdgcn_mfma_f32_32x32x16_bf16(k0, qr[0], c0, 0, 0, 0); p1 = __builtin_amdgcn_mfma_f32_32x32x16_bf16(k1, qr[0], c0, 0, 0, 0); }
            else { p0 = __builtin_amdgcn_mfma_f32_32x32x16_bf16(k0, qr[d0], p0, 0, 0, 0); p1 = __builtin_amdgcn_mfma_f32_32x32x16_bf16(k1, qr[d0], p1, 0, 0, 0); }
        }
    };
    auto cmask = [&](f32x16& p0, f32x16& p1, int jd) { const int rel = 64 * jd - 32 * wid;
        if (rel + 63 > 0) { const int d = r32 - rel - 4 * hi;
#pragma unroll
            for (int r = 0; r < 16; ++r) { const int c = (r & 3) + 8 * (r >> 2); if (c > d) p0[r] = -INFINITY; if (c + 32 > d) p1[r] = -INFINITY; } } };
    auto rowmax = [&](const f32x16& p0, const f32x16& p1) -> float {
        float a = max3f(p0[0], p0[1], p1[0]), b = max3f(p0[2], p0[3], p1[1]); a = max3f(a, p1[2], p1[3]);
#pragma unroll
        for (int r = 4; r < 16; r += 4) { a = max3f(a, p0[r], p0[r + 1]); b = max3f(b, p0[r + 2], p0[r + 3]); a = max3f(a, p1[r], p1[r + 1]); b = max3f(b, p1[r + 2], p1[r + 3]); }
        const float mx = max2f(a, b);
        auto rr = __builtin_amdgcn_permlane32_swap(__float_as_uint(mx), __float_as_uint(mx), false, false); return max2f(__uint_as_float(rr[0]), __uint_as_float(rr[1])); };
    dma_k(tile_kv0(0), 0);
    ATT_WAITBAR();
    f32x16 pA0 = zero16, pA1 = zero16, pB0 = zero16, pB1 = zero16;
#define ATT_SB() __builtin_amdgcn_sched_barrier(0)
#define ATT_PIN(x) asm volatile("" : "+v"(x))
#define ATT_SUMPACK(P0, P1, i) do { constexpr int e_ = ((i) & 3) * 4; \
        if ((i) < 4) { psa += P0[e_] + P0[e_ + 1]; psb += P0[e_ + 2] + P0[e_ + 3]; pw[(i) >> 1][2 * ((i) & 1)] = cvt_pk_bf16(P0[e_], P0[e_ + 1]); pw[(i) >> 1][2 * ((i) & 1) + 1] = cvt_pk_bf16(P0[e_ + 2], P0[e_ + 3]); } \
        else { psa += P1[e_] + P1[e_ + 1]; psb += P1[e_ + 2] + P1[e_ + 3]; pw[(i) >> 1][2 * ((i) & 1)] = cvt_pk_bf16(P1[e_], P1[e_ + 1]); pw[(i) >> 1][2 * ((i) & 1) + 1] = cvt_pk_bf16(P1[e_ + 2], P1[e_ + 3]); } \
        if (MODE == 1) { pw[(i) >> 1][2 * ((i) & 1)] = rowok_p ? pw[(i) >> 1][2 * ((i) & 1)] : 0u; pw[(i) >> 1][2 * ((i) & 1) + 1] = rowok_p ? pw[(i) >> 1][2 * ((i) & 1) + 1] : 0u; } \
        ATT_PIN(psa); ATT_PIN(psb); ATT_PIN(pw[(i) >> 1]); } while (0)
#define ATT_EXP(S0, S1, i) do { constexpr int e_ = ((i) & 3) * 4; \
        if ((i) < 4) { _Pragma("unroll") for (int j_ = 0; j_ < 4; ++j_) S0[e_ + j_] = __builtin_amdgcn_exp2f(NEGM ? S0[e_ + j_] : S0[e_ + j_] - m_run); ATT_PIN(S0); } \
        else { _Pragma("unroll") for (int j_ = 0; j_ < 4; ++j_) S1[e_ + j_] = __builtin_amdgcn_exp2f(NEGM ? S1[e_ + j_] : S1[e_ + j_] - m_run); ATT_PIN(S1); } } while (0)
#define ATT_KLD(i) (*(LAS const bf16x8*)(Kt_ + ((i) >> 1) * 2048 + ((i) & 1) * 512))
#define ATT_VLD(j) do { const int db_ = (j) >> 2, ks_ = (j) & 3; vlo[(j) & 7] = vtr(Vt_ + db_ * 4096 + ks_ * 1024); vhi[(j) & 7] = vtr(Vt_ + db_ * 4096 + ks_ * 1024 + 512); } while (0)
#define ATT_QK(P0, P1, S0, S1, i, HASPV) do { if ((i) + 2 < NMF) kf[((i) + 2) % 3] = ATT_KLD((i) + 2); \
        if ((i) & 1) S1 = __builtin_amdgcn_mfma_f32_32x32x16_bf16(kf[(i) % 3], qr[(i) >> 1], (i) == 1 ? ci : S1, 0, 0, 0); \
        else S0 = __builtin_amdgcn_mfma_f32_32x32x16_bf16(kf[(i) % 3], qr[(i) >> 1], (i) == 0 ? ci : S0, 0, 0, 0); \
        if (HASPV && (i) < 8) { ATT_VLD(i); if (LAG || (i) < 6) ATT_SUMPACK(P0, P1, i); } \
        ATT_SB(); } while (0)
#define ATT_PV(S0, S1, j, HASQK) do { \
        { const s16x4 lo_ = vlo[(j) & 7], hh_ = vhi[(j) & 7]; const bf16x8 vf_ = (bf16x8){lo_[0], lo_[1], lo_[2], lo_[3], hh_[0], hh_[1], hh_[2], hh_[3]}; \
          o[(j) >> 2] = __builtin_amdgcn_mfma_f32_32x32x16_bf16(__builtin_bit_cast(bf16x8, pw[(j) & 3]), vf_, o[(j) >> 2], 0, 0, 0); } \
        if ((j) + 8 < NPV) ATT_VLD((j) + 8); \
        if (HASQK && (j) < 8) ATT_EXP(S0, S1, j); \
        ATT_SB(); } while (0)
#define ATT_STEP(P0, P1, S0, S1, t, HASQK, HASPV) do { \
        constexpr int NMF = DK / 8, NPV = DV / 8; \
        if (HASQK || (t) < NT) { if ((t) + 1 < NT) dma_k(tile_kv0((t) + 1), ((t) + 1) & 1); dma_v(tile_kv0(t), (t) & 1); }     \
        float psa = LAG ? lsa : 0.f, psb = LAG ? lsb : 0.f; u32x4 pw[4]; s16x4 vlo[8], vhi[8]; \
        const bool rowok_p = (MODE != 1) || ((t) - 1 < 4) || ((sel >> ((((t) - 1 - 4) >> 2) & 31)) & 1u);     \
        const bool rowok_s = (MODE != 1) || ((t) < 4) || ((sel >> ((((t) - 4) >> 2) & 31)) & 1u); \
        LAS const unsigned char* Vt_ = kv + 2 * KB + (((t) + 1) & 1) * VB + ((lane >> 4) & 1) * 32 + (lane & 3) * 8 + (4 * hi + ((lane & 15) >> 2)) * 64;     \
          \
        if (HASQK) { \
            const f32x16 ci = NEGM ? negm : zero16; \
            LAS const unsigned char* Kt_ = kv + ((t) & 1) * KB + hi * 1024 + r32 * 16; \
            bf16x8 kf[3]; kf[0] = ATT_KLD(0); kf[1] = ATT_KLD(1); ATT_SB(); \
            ATT_QK(P0, P1, S0, S1, 0, HASPV); ATT_QK(P0, P1, S0, S1, 1, HASPV); ATT_QK(P0, P1, S0, S1, 2, HASPV); ATT_QK(P0, P1, S0, S1, 3, HASPV); \
            ATT_QK(P0, P1, S0, S1, 4, HASPV); ATT_QK(P0, P1, S0, S1, 5, HASPV); ATT_QK(P0, P1, S0, S1, 6, HASPV); ATT_QK(P0, P1, S0, S1, 7, HASPV); \
            if (NMF == 12) { ATT_QK(P0, P1, S0, S1, 8, HASPV); ATT_QK(P0, P1, S0, S1, 9, HASPV); ATT_QK(P0, P1, S0, S1, 10, HASPV); ATT_QK(P0, P1, S0, S1, 11, HASPV); } \
        } else { ATT_VLD(0); ATT_VLD(1); ATT_VLD(2); ATT_VLD(3); ATT_VLD(4); ATT_VLD(5); ATT_VLD(6); ATT_VLD(7); \
            ATT_SUMPACK(P0, P1, 0); ATT_SUMPACK(P0, P1, 1); ATT_SUMPACK(P0, P1, 2); ATT_SUMPACK(P0, P1, 3); ATT_SUMPACK(P0, P1, 4); ATT_SUMPACK(P0, P1, 5); ATT_SUMPACK(P0, P1, 6); ATT_SUMPACK(P0, P1, 7); } \
        if (!LAG && HASQK && HASPV) { ATT_SUMPACK(P0, P1, 6); ATT_SUMPACK(P0, P1, 7); ATT_SB(); }     \
        if (LAG) { lsa = psa; lsb = psb; } else if (HASPV) l_run += rowok_p ? (psa + psb) : 0.f; \
          \
        bool resc = false; float al = 1.f; \
        if (HASQK && LAG && HASPV) { const int jd_ = tile_jd(t); if (jd_ >= 0) cmask(S0, S1, jd_); }     \
        else if (HASQK) { const int jd_ = tile_jd(t); if (jd_ >= 0) cmask(S0, S1, jd_); \
            asm volatile("s_nop 11" : "+v"(S0), "+v"(S1));     \
            float mx = rowmax(S0, S1); if (!NEGM) mx -= m_run; if (MODE == 1) mx = rowok_s ? mx : -INFINITY; \
            if ((t) == 0 || !__all(mx <= THR)) {                      \
                const float dl = ((t) == 0) ? mx : ((mx > THR) ? mx : 0.f); m_run += dl;     \
                if (NEGM) { _Pragma("unroll") for (int r = 0; r < 16; ++r) { S0[r] -= dl; S1[r] -= dl; negm[r] = -m_run; } } \
                if ((t) != 0) { al = __builtin_amdgcn_exp2f(-dl); l_run *= al; resc = true; } } } \
          \
        if (HASPV) { ATT_SB(); \
            ATT_PV(S0, S1, 0, HASQK); ATT_PV(S0, S1, 1, HASQK); ATT_PV(S0, S1, 2, HASQK); ATT_PV(S0, S1, 3, HASQK); ATT_PV(S0, S1, 4, HASQK); ATT_PV(S0, S1, 5, HASQK); ATT_PV(S0, S1, 6, HASQK); ATT_PV(S0, S1, 7, HASQK); \
            if (NPV == 16) { ATT_PV(S0, S1, 8, HASQK); ATT_PV(S0, S1, 9, HASQK); ATT_PV(S0, S1, 10, HASQK); ATT_PV(S0, S1, 11, HASQK); ATT_PV(S0, S1, 12, HASQK); ATT_PV(S0, S1, 13, HASQK); ATT_PV(S0, S1, 14, HASQK); ATT_PV(S0, S1, 15, HASQK); } \
        } else { ATT_EXP(S0, S1, 0); ATT_EXP(S0, S1, 1); ATT_EXP(S0, S1, 2); ATT_EXP(S0, S1, 3); ATT_EXP(S0, S1, 4); ATT_EXP(S0, S1, 5); ATT_EXP(S0, S1, 6); ATT_EXP(S0, S1, 7); } \
          \
        if (resc) { if (hi == 0) wsf[r32] = al; \
            asm volatile("s_waitcnt lgkmcnt(0)" ::: "memory"); \
            _Pragma("unroll") for (int a_ = 0; a_ < 4; ++a_) { const f32x4 av = *(LAS const f32x4*)(wsf + 8 * a_ + 4 * hi); \
                _Pragma("unroll") for (int d = 0; d < DV / 32; ++d) { o[d][4 * a_ + 0] *= av.x; o[d][4 * a_ + 1] *= av.y; o[d][4 * a_ + 2] *= av.z; o[d][4 * a_ + 3] *= av.w; } } } \
        ATT_WAITBAR(); } while (0)
    const int NTw = (ATT_SKIPDEAD && (MODE == 0 || MODE == 2) && wid < 4) ? NT - 2 : NT;
    ATT_STEP(pB0, pB1, pA0, pA1, 0, true, false);
    int t = 1;
    for (; t + 2 < NTw; t += 2) { ATT_STEP(pA0, pA1, pB0, pB1, t, true, true); ATT_STEP(pB0, pB1, pA0, pA1, t + 1, true, true); }
    ATT_STEP(pA0, pA1, pB0, pB1, t, true, true);
    ATT_STEP(pB0, pB1, pA0, pA1, NTw, false, true);
    for (t = NTw + 1; t <= NT; ++t) { if (t < NT) { if (t + 1 < NT) dma_k(tile_kv0(t + 1), (t + 1) & 1); dma_v(tile_kv0(t), t & 1); } ATT_WAITBAR(); }
#undef ATT_STEP
#undef ATT_PV
#undef ATT_VLD
#undef ATT_QK
#undef ATT_KLD
#undef ATT_EXP
#undef ATT_SUMPACK
#undef ATT_PIN
#undef ATT_SB
    if (LAG) l_run = lsa + lsb;
    { auto rr = __builtin_amdgcn_permlane32_swap(__float_as_uint(l_run), __float_as_uint(l_run), false, false); l_run = __uint_as_float(rr[0]) + __uint_as_float(rr[1]); }
    m_out = m_run; l_out = l_run;
    if (hi == 0) wsf[32 + r32] = __builtin_amdgcn_rcpf(l_run);
    asm volatile("s_waitcnt lgkmcnt(0)" ::: "memory");
#pragma unroll
    for (int a = 0; a < 4; ++a) { const f32x4 av = *(LAS const f32x4*)(wsf + 32 + 8 * a + 4 * hi);
#pragma unroll
        for (int d = 0; d < DV / 32; ++d) { o[d][4 * a + 0] *= av.x; o[d][4 * a + 1] *= av.y; o[d][4 * a + 2] *= av.z; o[d][4 * a + 3] *= av.w; } }
    bool bad_ = false;
    if (LAG) { float os = 0.f;
#pragma unroll
        for (int d = 0; d < DV / 32; ++d)
#pragma unroll
            for (int r = 0; r < 16; ++r) os += __builtin_fabsf(o[d][r]);
        bad_ = !(l_run <= 1e30f) || !(os <= 1e30f); }
    return bad_;
}
template <int DK, int DV, int MODE>
__device__ __forceinline__ void attn_unit_safe(LAS unsigned char* kv, LAS float* wsf, const bf16_t* qrow, const bf16_t* Kb, int ldk, const bf16_t* Krb, const bf16_t* Vb, int ldv,
                                               int qb, unsigned sel, f32x16 (&o)[DV / 32], float& m_out, float& l_out) {
    const bool bad = attn_unit<DK, DV, MODE, true>(kv, wsf, qrow, Kb, ldk, Krb, Vb, ldv, qb, sel, o, m_out, l_out);
    LAS int* flag = (LAS int*)((LAS unsigned char*)lds_raw + LDS_MISC + LM_QSLOT) + 4;
    const int t_ = my_tid();
    if (t_ == 0) *flag = 0;
    __syncthreads();
    if (__builtin_amdgcn_ballot_w64(bad) != 0ull && (t_ & 63) == 0) *flag = 1;
    __syncthreads();
    if (*flag != 0) attn_unit<DK, DV, MODE, false>(kv, wsf, qrow, Kb, ldk, Krb, Vb, ldv, qb, sel, o, m_out, l_out);
}
template <int ND> __device__ __forceinline__ void store_o(const f32x16 (&o)[ND], bf16_t* dst, int ld, int r32, int hi) {
#pragma unroll
    for (int r = 0; r < 16; ++r)
#pragma unroll
        for (int db = 0; db < ND; ++db) dst[(size_t)crow(r, hi) * ld + db * 32 + r32] = (bf16_t)(cvt_pk_bf16(o[db][r], 0.f) & 0xffffu);
}
struct Queue { unsigned* heads; int per; LAS int* slot; int own, cur; };
__device__ __forceinline__ int queue_next(Queue& q) {
    __syncthreads();
    if (my_tid() == 0) { int item = -1;
        while (q.cur < 8) { const int qi = (q.own + q.cur) & 7; const unsigned i = __hip_atomic_fetch_add(q.heads + 64 * qi, 1u, __ATOMIC_RELAXED, __HIP_MEMORY_SCOPE_AGENT);
            if (i < (unsigned)q.per) { item = qi * q.per + (int)i; break; } ++q.cur; }
        q.slot[0] = item; }
    __syncthreads();
    const int it = __builtin_amdgcn_readfirstlane(q.slot[0]);
    return it;
}
}

struct PrepSrc { const float* W; const float* W2; const float* g; };
__device__ __forceinline__ f32x4 prep_fetch4(int mode, const PrepSrc& s, int p, int kk) {
    const f32x4 z = {0.f, 0.f, 0.f, 0.f};
    switch (mode) {
    case 0: return __builtin_nontemporal_load((const f32x4*)(s.W + (size_t)kk * EVEN_IN + win0_truecol(p))) * s.g[kk];
    case 1: return __builtin_nontemporal_load((const f32x4*)(s.W + (size_t)kk * DM + perm8(p)));
    case 2: return (p < ODD_IN) ? __builtin_nontemporal_load((const f32x4*)(s.W + (size_t)kk * ODD_IN + (p < 384 ? perm8(p) : p))) * s.g[kk] : z;
    case 3: return __builtin_nontemporal_load((const f32x4*)(s.W + (size_t)kk * 1536 + qup_truecol(p))) * s.g[kk];
    case 4: return __builtin_nontemporal_load((const f32x4*)(s.W + (size_t)kk * 2048 + perm8(p))) * s.g[kk];
    case 5: { const int e = p >> 9, r = p & 511, hf = r >> 8, rr = r & 255; const ptrdiff_t dlt = (rr < 128) ? (ptrdiff_t)0 : (s.W2 - s.W);
              return __builtin_nontemporal_load((const f32x4*)(s.W + dlt + (ptrdiff_t)(((size_t)e * DM + kk) * FF + hf * 128 + perm8(rr & 127)))) * s.g[kk]; }
    case 6: { const int e = p >> 10, n = perm8(p & 1023); return __builtin_nontemporal_load((const f32x4*)(s.W + ((size_t)e * FF + kk) * DM + n)); }
    default: return (p < 4) ? __builtin_nontemporal_load((const f32x4*)(s.W + (size_t)kk * 4)) * s.g[kk] : (p < 36) ? __builtin_nontemporal_load((const f32x4*)(s.W2 + (size_t)kk * 32 + (p - 4))) * s.g[kk] : z;
    }
}
__device__ __forceinline__ void prep_item(int mode, const PrepSrc& s, bf16_t* out, int P, int Kt, int item, LAS float* scr, int lane) {
    const int nkb = Kt >> 6, pb = item / nkb, kb = item - pb * nkb, p0 = pb * 64, k0 = kb * 64;
#pragma unroll 4
    for (int i = 0; i < 16; ++i) { const int kk = 4 * i + (lane >> 4), n = (lane & 15) * 4; const f32x4 v = prep_fetch4(mode, s, p0 + n, k0 + kk);
        LAS float* t = scr + kk * 64; t[(n + kk) & 63] = v.x; t[(n + 1 + kk) & 63] = v.y; t[(n + 2 + kk) & 63] = v.z; t[(n + 3 + kk) & 63] = v.w; }
    asm volatile("s_waitcnt lgkmcnt(0)" ::: "memory");
    const int c = lane & 7;
#pragma unroll
    for (int j = 0; j < 8; ++j) { const int n = (lane >> 3) + 8 * j; const LAS float* t = scr + (8 * c) * 64; const int b = n + 8 * c;
#define PREP_T(i) t[(i) * 64 + ((b + (i)) & 63)]
        u32x4 o; o.x = cvt_pk_bf16(PREP_T(0), PREP_T(1)); o.y = cvt_pk_bf16(PREP_T(2), PREP_T(3)); o.z = cvt_pk_bf16(PREP_T(4), PREP_T(5)); o.w = cvt_pk_bf16(PREP_T(6), PREP_T(7));
#undef PREP_T
        if (p0 + n < P) *(u32x4*)(out + (size_t)(p0 + n) * Kt + k0 + 8 * c) = o; }
    asm volatile("s_waitcnt lgkmcnt(0)" ::: "memory");
}
__device__ __forceinline__ void prep_matrix(int mode, const float* W, const float* W2, const float* g, bf16_t* out, int P, int Kt, LAS float* scr, int gw, int ngw, int lane, int& off) {
    PrepSrc s{W, W2, g}; const int items = ((P + 63) >> 6) * (Kt >> 6);
    int it = gw - (off % ngw); if (it < 0) it += ngw;
    for (; it < items; it += ngw) prep_item(mode, s, out, P, Kt, it, scr, lane);
    off += items;
}
template <bool XBF> __device__ __forceinline__ void row_phase(const void* xin, const bf16_t* Y, bf16_t* xb, float* rstd, const float* gfin, float* fin, int gw, int ngw, int lane) {
    auto ld = [&](int row, f32x4 (&v)[4]) {
#pragma unroll
        for (int j = 0; j < 4; ++j) {
            if (XBF) { const u32x2 r = *((const u32x2*)((const bf16_t*)xin + (size_t)row * DM) + lane + 64 * j);
                v[j] = (f32x4){bf2f((unsigned short)(r.x & 0xffff)), bf2f((unsigned short)(r.x >> 16)), bf2f((unsigned short)(r.y & 0xffff)), bf2f((unsigned short)(r.y >> 16))}; }
            else v[j] = __builtin_nontemporal_load((const f32x4*)((const float*)xin + (size_t)row * DM) + lane + 64 * j);
            if (Y) {
                const u32x2 y0 = __builtin_nontemporal_load((const u32x2*)(Y + (size_t)(2 * row) * DM) + lane + 64 * j), y1 = __builtin_nontemporal_load((const u32x2*)(Y + (size_t)(2 * row + 1) * DM) + lane + 64 * j);
                v[j].x += bf2f((unsigned short)(y0.x & 0xffff)) + bf2f((unsigned short)(y1.x & 0xffff)); v[j].y += bf2f((unsigned short)(y0.x >> 16)) + bf2f((unsigned short)(y1.x >> 16));
                v[j].z += bf2f((unsigned short)(y0.y & 0xffff)) + bf2f((unsigned short)(y1.y & 0xffff)); v[j].w += bf2f((unsigned short)(y0.y >> 16)) + bf2f((unsigned short)(y1.y >> 16));
            } } };
    auto fn = [&](int row, const f32x4 (&v)[4]) { float s = 0.f;
#pragma unroll
        for (int j = 0; j < 4; ++j) s += (v[j].x * v[j].x + v[j].y * v[j].y) + (v[j].z * v[j].z + v[j].w * v[j].w);
        const float rs = 1.0f / sqrtf(wave_sum(s) * (1.0f / DM) + NORM_EPS);
        if (rstd && lane == 0) rstd[row] = rs;
#pragma unroll
        for (int j = 0; j < 4; ++j) {
            if (xb) { u32x2 w; w.x = cvt_pk_bf16(v[j].x, v[j].y); w.y = cvt_pk_bf16(v[j].z, v[j].w); *((u32x2*)(xb + (size_t)row * DM) + lane + 64 * j) = w; }
            if (fin) { const f32x4 g = *((const f32x4*)gfin + lane + 64 * j); __builtin_nontemporal_store(v[j] * rs * g, (f32x4*)(fin + (size_t)row * DM) + lane + 64 * j); }
        } };
    for (int row = gw; row < NT; row += 2 * ngw) { const int row2 = row + ngw; const bool two = row2 < NT;
        f32x4 va[4], vb[4]; ld(row, va); if (two) ld(row2, vb);
        fn(row, va); if (two) fn(row2, vb); }
}

#define XB_TMO      128
#define XB_XCNT(j)  (256  + 64 * (j))
#define XB_XSUB(j)  (1280 + 64 * (j))
#define XB_XGEN(j)  (2304 + 64 * (j))
#define XB_TOP      3328
#define XB_TOPGEN   3392
#define XCD_BAR_WORDS 3456
#define XB_SPIN_CAP (1u << 18)
__device__ __forceinline__ unsigned xb_ld(unsigned* p)              { return __hip_atomic_load(p, __ATOMIC_RELAXED, __HIP_MEMORY_SCOPE_AGENT); }
__device__ __forceinline__ unsigned xb_add(unsigned* p, unsigned v) { return __hip_atomic_fetch_add(p, v, __ATOMIC_RELAXED, __HIP_MEMORY_SCOPE_AGENT); }
__device__ __forceinline__ unsigned xb_xcc_id() { return (unsigned)__builtin_amdgcn_s_getreg((3 << 11) | 20) & 0xFu; }
#define XB_SPIN(cond, bar) do { unsigned _sp = 0; while (cond) { __builtin_amdgcn_s_sleep(1); \
    if ((++_sp & 255u) == 0u) { if (xb_ld(&(bar)[XB_TMO])) break; if (_sp > XB_SPIN_CAP) { atomicAdd(&(bar)[XB_TMO], 1u); break; } } } } while (0)
struct XcdBarrier { unsigned* bar; unsigned x; volatile LAS unsigned* st; };
__device__ __forceinline__ XcdBarrier xcd_barrier_post(unsigned* bar, volatile LAS unsigned* st) {
    XcdBarrier b; b.bar = bar; b.x = xb_xcc_id(); b.st = st;
    if (my_tid() == 0) (void)xb_add(&bar[XB_XCNT(b.x)], 1u);
    return b;
}
__device__ __forceinline__ void xcd_barrier_complete(unsigned* bar, unsigned x, unsigned& nloc, unsigned& nx) {
    const unsigned G = gridDim.x * gridDim.y * gridDim.z;
    unsigned sum, cnt, mine, sp = 0u;
    for (;;) {
        sum = 0u; cnt = 0u; mine = 0u;
#pragma unroll
        for (unsigned j = 0; j < 16; ++j) { const unsigned c = xb_ld(&bar[XB_XCNT(j)]); sum += c; cnt += (c > 0u) ? 1u : 0u; mine = (j == x) ? c : mine; }
        if (sum == G) break;
        __builtin_amdgcn_s_sleep(1);
        if ((++sp & 255u) == 0u) { if (xb_ld(&bar[XB_TMO])) break; if (sp > XB_SPIN_CAP) { atomicAdd(&bar[XB_TMO], 1u); break; } }
    }
    nloc = mine > 0u ? mine : 1u; nx = cnt > 0u ? cnt : 1u;
}
__device__ __forceinline__ void xcd_barrier(const XcdBarrier& b) {
    asm volatile("s_waitcnt vmcnt(0)" ::: "memory");
    __syncthreads();
    if (my_tid() == 0) {
        unsigned* bar = b.bar;
        __builtin_amdgcn_s_waitcnt(0);
        unsigned nloc = b.st[0], nx = b.st[1];
        if (nloc == 0u) { xcd_barrier_complete(bar, b.x, nloc, nx); b.st[0] = nloc; b.st[1] = nx; }
        const unsigned old = xb_add(&bar[XB_XSUB(b.x)], 1u);
        const unsigned gen = old / nloc;
        if (old + 1u == (gen + 1u) * nloc) {
            __builtin_amdgcn_fence(__ATOMIC_RELEASE, "agent");
            asm volatile("s_waitcnt vmcnt(0)" ::: "memory");
            const unsigned og = xb_add(&bar[XB_TOP], 1u);
            const unsigned tg = og / nx;
            if (og + 1u == (tg + 1u) * nx) xb_add(&bar[XB_TOPGEN], 1u);
            else XB_SPIN(xb_ld(&bar[XB_TOPGEN]) == tg, bar);
            __builtin_amdgcn_fence(__ATOMIC_ACQUIRE, "agent");
            xb_add(&bar[XB_XGEN(b.x)], 1u);
            asm volatile("s_waitcnt vmcnt(0)" ::: "memory");
        } else {
            XB_SPIN(xb_ld(&bar[XB_XGEN(b.x)]) == gen, bar);
            __builtin_amdgcn_fence(__ATOMIC_ACQUIRE, "agent");
            asm volatile("s_waitcnt vmcnt(0)" ::: "memory");
        }
    }
    __syncthreads();
}

constexpr size_t CTL_BAR = 16384;
struct MArgs { const float* in[24]; float* out; unsigned char* ws; int ph_lo, ph_hi; };
typedef __attribute__((address_space(4))) const MArgs* CArgsPtr;
#define PHASE_ENV() CArgsPtr ap_ = (CArgsPtr)__builtin_amdgcn_kernarg_segment_ptr(); asm volatile("" : "+s"(ap_)); unsigned char* const ws = ap_->ws; (void)ws; \
    float* const X = ap_->out; (void)X; float* const rstd = (float*)(ws + WS_RSTD); (void)rstd; bf16_t* const XB = (bf16_t*)(ws + WS_XB); (void)XB; bf16_t* const OMIX = (bf16_t*)(ws + WS_OMIX); (void)OMIX;
#define ARG_IN(k) (ap_->in[k])
template <int rep> __device__ __forceinline__ void ph_prologue(LAS unsigned char* lds, const int G, const int bx) { const int tid = my_tid(); (void)tid; PHASE_ENV();
        const int wv = tid >> 6, lane = tid & 63, gw = bx * NWAVES + wv, ngw = G * NWAVES;
        LAS float* scr = (LAS float*)(lds + wv * 16384); int poff = 0;
        prep_matrix(0, ARG_IN(2), nullptr, ARG_IN(1), (bf16_t*)(ws + WS_W_IN0T), 3072, 1024, scr, gw, ngw, lane, poff);
        prep_matrix(1, ARG_IN(8), nullptr, nullptr, (bf16_t*)(ws + WS_W_OUT0T), 1024, 1024, scr, gw, ngw, lane, poff);
        for (int L = 0; L < 1; ++L) {
            prep_matrix(5, ARG_IN(20) + (size_t)L * NEXP * DM * FF, ARG_IN(21) + (size_t)L * NEXP * DM * FF, ARG_IN(15) + L * DM, (bf16_t*)(ws + WS_W_UPT) + (size_t)L * NEXP * 512 * DM, NEXP * 512, 1024, scr, gw, ngw, lane, poff);
            prep_matrix(6, ARG_IN(22) + (size_t)L * NEXP * FF * DM, nullptr, nullptr, (bf16_t*)(ws + WS_W_DNT) + (size_t)L * NEXP * DM * FF, NEXP * 1024, 256, scr, gw, ngw, lane, poff);
            prep_matrix(7, ARG_IN(16) + (size_t)L * DM * 4, ARG_IN(18) + (size_t)L * DM * 32, ARG_IN(15) + L * DM, (bf16_t*)(ws + WS_W_RT) + (size_t)L * 48 * DM, 48, 1024, scr, gw, ngw, lane, poff);
        }
        { f32x2* cs64 = (f32x2*)(ws + WS_CS64); f32x2* cs32 = (f32x2*)(ws + WS_CS32);
          const int i = tid & 31;
          const float inv = 1.0f / (float)exp(9.210340371976184 * ((double)(2 * i) / 64.0));
          for (int idx = bx * NTHREADS + tid; idx < SEQ * 32; idx += G * NTHREADS) { const int t = idx >> 5;
              const float ang = (float)t * inv; double s, c; sincos_d((double)ang, s, c); const f32x2 v = {(float)c, (float)s}; cs64[idx] = v;
              if (!(i & 1)) cs32[t * 16 + (i >> 1)] = v; } }
        row_phase<false>(ARG_IN(0), nullptr, XB, rstd, nullptr, nullptr, gw, ngw, lane);
    }
template <int CHUNK> __device__ __forceinline__ void ph_prep_late(LAS unsigned char* lds, const int G, const int bx, const int gw, const int ngw) { const int tid = my_tid(); (void)tid; PHASE_ENV();
        const int wv = tid >> 6, lane = tid & 63; LAS float* scr = (LAS float*)(lds + wv * 16384); int poff = 0;
        if (CHUNK == 0) {
            prep_matrix(2, ARG_IN(9), nullptr, ARG_IN(1) + DM, (bf16_t*)(ws + WS_W_IN1T), 512, 1024, scr, gw, ngw, lane, poff);
            prep_matrix(3, ARG_IN(12), nullptr, ARG_IN(10), (bf16_t*)(ws + WS_W_QUPT), 1536, 256, scr, gw, ngw, lane, poff);
            prep_matrix(4, ARG_IN(13), nullptr, ARG_IN(11), (bf16_t*)(ws + WS_W_KVUPT), 2048, 128, scr, gw, ngw, lane, poff);
            prep_matrix(1, ARG_IN(14), nullptr, nullptr, (bf16_t*)(ws + WS_W_OUT1T), 1024, 1024, scr, gw, ngw, lane, poff);
            prep_matrix(7, ARG_IN(16) + (size_t)DM * 4, ARG_IN(18) + (size_t)DM * 32, ARG_IN(15) + DM, (bf16_t*)(ws + WS_W_RT) + (size_t)48 * DM, 48, 1024, scr, gw, ngw, lane, poff); }
        if (CHUNK == 0) prep_matrix(5, ARG_IN(20) + (size_t)NEXP * DM * FF, ARG_IN(21) + (size_t)NEXP * DM * FF, ARG_IN(15) + DM, (bf16_t*)(ws + WS_W_UPT) + (size_t)NEXP * 512 * DM, NEXP * 512, 1024, scr, gw, ngw, lane, poff);
        if (CHUNK == 2) prep_matrix(6, ARG_IN(22) + (size_t)NEXP * FF * DM, nullptr, nullptr, (bf16_t*)(ws + WS_W_DNT) + (size_t)NEXP * DM * FF, NEXP * 1024, 256, scr, gw, ngw, lane, poff);
    }
template <int CHUNK> __device__ __forceinline__ void prep_in_tail(LAS unsigned char* lds, const int G, const int bx, const int U) { const int r = U % G, wv = my_tid() >> 6;
        if ((G - r) * 4 < G) ph_prep_late<CHUNK>(lds, G, bx, bx * NWAVES + wv, G * NWAVES);
        else if (bx >= r) ph_prep_late<CHUNK>(lds, G, bx, (bx - r) * NWAVES + wv, (G - r) * NWAVES); }
template <int rep> __device__ __forceinline__ void ph_win0(LAS unsigned char* lds, const int G, const int bx) { const int tid = my_tid(); (void)tid; PHASE_ENV();
        pg8::DenseSched S; S.init(XB, DM * 2, ws + WS_W_IN0T, NT, EVEN_IN, DM, G, bx);
        pg8::EpiWin0 E{rstd, (const f32x2*)(ws + WS_CS64), (bf16_t*)(ws + WS_QKV0), (float*)(ws + CTL_KMEAN)};
        pg8::gemm_phase<pg8::EpiWin0, pg8::DenseSched, true, true>(lds, DM, S, E);
    }
template <int rep> __device__ __forceinline__ void ph_moba_own(LAS unsigned char* lds, const int G, const int bx) { const int tid = my_tid(); (void)tid; PHASE_ENV();
    att::Queue q; q.heads = (unsigned*)(ws + CTL_Q2 + rep * 4096); q.per = 128; q.slot = (LAS int*)(lds + LDS_MISC + LM_QSLOT); q.own = (int)(xb_xcc_id() & 7u); q.cur = 0;
    const bf16_t* QKV = (const bf16_t*)(ws + WS_QKV0);
    int* lcnt = (int*)(ws + CTL_LCNT); int* lst = (int*)(ws + WS_LST); f32x2* pml = (f32x2*)(ws + WS_PML);
    for (int it = att::queue_next(q); it >= 0; it = att::queue_next(q)) {
        int tid_o = my_tid(); asm volatile("" : "+v"(tid_o)); const int tid_i = tid_o; const int wv = tid_i >> 6, lane = tid_i & 63, r32 = lane & 31, hi = lane >> 5;
        LAS float* wsf = (LAS float*)(lds + LDS_MISC + LM_ATTN) + wv * 64;
        const int g = it >> 7, i = it & 127, mbh = 4 * g + (i >> 5), qb = 31 - (i & 31), b = mbh >> 3, h = mbh & 7;
        const bf16_t* Qw = QKV + ((size_t)b * SEQ + qb * 256) * EVEN_IN + h * 64; const bf16_t* Kb = QKV + (size_t)b * SEQ * EVEN_IN + 512 + h * 64; const bf16_t* Vb = QKV + (size_t)b * SEQ * EVEN_IN + 1024 + h * 64;
        const bf16_t* qrow = Qw + (size_t)(wv * 32 + r32) * EVEN_IN; const int qpos = qb * 256 + wv * 32 + r32;
        LAS float* km = (LAS float*)(lds + 32768);
        { const float* kmg = (const float*)(ws + CTL_KMEAN) + (size_t)(b * 8 + h) * 2048; *(LAS f32x4*)(km + tid_i * 4) = *(const f32x4*)(kmg + tid_i * 4); }
        __syncthreads();
        { float qf[32];
#pragma unroll
          for (int d0 = 0; d0 < 4; ++d0) { const bf16x8 qv = *(const bf16x8*)(qrow + d0 * 16 + hi * 8);
#pragma unroll
              for (int jj = 0; jj < 8; ++jj) qf[d0 * 8 + jj] = bf2f((unsigned short)qv[jj]); }
          float b0 = -INFINITY, b1 = -INFINITY, b2 = -INFINITY; int i0 = -1, i1 = -1, i2 = -1;
          for (int jb = 0; jb < qb; ++jb) { float s = 0.f;
#pragma unroll
              for (int d0 = 0; d0 < 4; ++d0) { const f32x4 k0 = *(LAS const f32x4*)(km + jb * 64 + d0 * 16 + hi * 8), k1 = *(LAS const f32x4*)(km + jb * 64 + d0 * 16 + hi * 8 + 4);
                  s = fmaf(qf[d0 * 8 + 0], k0.x, s); s = fmaf(qf[d0 * 8 + 1], k0.y, s); s = fmaf(qf[d0 * 8 + 2], k0.z, s); s = fmaf(qf[d0 * 8 + 3], k0.w, s);
                  s = fmaf(qf[d0 * 8 + 4], k1.x, s); s = fmaf(qf[d0 * 8 + 5], k1.y, s); s = fmaf(qf[d0 * 8 + 6], k1.z, s); s = fmaf(qf[d0 * 8 + 7], k1.w, s); }
              { auto rr = __builtin_amdgcn_permlane32_swap(__float_as_uint(s), __float_as_uint(s), false, false); s = __uint_as_float(rr[0]) + __uint_as_float(rr[1]); }
              if (s > b0) { b2 = b1; i2 = i1; b1 = b0; i1 = i0; b0 = s; i0 = jb; } else if (s > b1) { b2 = b1; i2 = i1; b1 = s; i1 = jb; } else if (s > b2) { b2 = s; i2 = jb; } }
          LAS int* lc = (LAS int*)(lds + 32768 + 8192); LAS int* lbase = lc + 32;
          if (tid_i < 32) lc[tid_i] = 0;
          __syncthreads();
          int p0 = 0, p1 = 0, p2 = 0;
          if (hi == 0 && rep == 0) { if (i0 >= 0) p0 = __hip_atomic_fetch_add(lc + i0, 1, __ATOMIC_RELAXED, __HIP_MEMORY_SCOPE_WORKGROUP); if (i1 >= 0) p1 = __hip_atomic_fetch_add(lc + i1, 1, __ATOMIC_RELAXED, __HIP_MEMORY_SCOPE_WORKGROUP);
              if (i2 >= 0) p2 = __hip_atomic_fetch_add(lc + i2, 1, __ATOMIC_RELAXED, __HIP_MEMORY_SCOPE_WORKGROUP); }
          __syncthreads();
          const int lb = (b * 8 + h) * 32;
          if (tid_i < 32) { const int n = lc[tid_i]; lbase[tid_i] = n ? atomicAdd(lcnt + lb + tid_i, n) : 0; }
          __syncthreads();
          if (hi == 0 && rep == 0) {
              if (i0 >= 0) lst[lst_base(lb + i0) + lbase[i0] + p0] = (qpos << 2) | 0;
              if (i1 >= 0) lst[lst_base(lb + i1) + lbase[i1] + p1] = (qpos << 2) | 1;
              if (i2 >= 0) lst[lst_base(lb + i2) + lbase[i2] + p2] = (qpos << 2) | 2; } }
        f32x16 o[2]; float mo, lo;
        att::attn_unit_safe<64, 64, 2>(lds, wsf, qrow, Kb, EVEN_IN, nullptr, Vb, EVEN_IN, qb, 0u, o, mo, lo);
        att::store_o<2>(o, OMIX + ((size_t)b * SEQ + qb * 256 + wv * 32) * DM + h * 64, DM, r32, hi);
        if (hi == 0) pml[((size_t)3 * NT + (size_t)b * SEQ + qpos) * 8 + h] = (f32x2){mo, lo};
    }
}
template <int rep> __device__ __forceinline__ void ph_attn0b(LAS unsigned char* lds, const int G, const int bx) { const int tid = my_tid(); (void)tid; PHASE_ENV();
    const bf16_t* QKV = (const bf16_t*)(ws + WS_QKV0);
    const int* lcnt = (const int*)(ws + CTL_LCNT); const int* lst = (const int*)(ws + WS_LST); f32x2* pml = (f32x2*)(ws + WS_PML);
    LAS int* pre = (LAS int*)(lds + LDS_MISC + LM_ROWOFF);
    if (tid < 64) { int c[16]; int sum = 0;
#pragma unroll
        for (int k = 0; k < 16; ++k) { c[k] = (lcnt[tid * 16 + k] + 255) >> 8; sum += c[k]; }
        int inc = sum;
#pragma unroll
        for (int ofs = 1; ofs < 64; ofs <<= 1) { const int v = __shfl_up(inc, ofs); if (tid >= ofs) inc += v; }
        int run = inc - sum;
#pragma unroll
        for (int k = 0; k < 16; ++k) { pre[tid * 16 + k] = run; run += c[k]; }
        if (tid == 63) pre[1024] = run; }
    __syncthreads();
    float lam;
    { const float* lq1 = ARG_IN(3); const float* lk1 = ARG_IN(4); const float* lq2 = ARG_IN(5); const float* lk2 = ARG_IN(6); float s1 = 0.f, s2 = 0.f;
      for (int i = 0; i < 64; ++i) { s1 += lq1[i] * lk1[i]; s2 += lq2[i] * lk2[i]; }
      lam = expf(s1) - expf(s2) + LAM_INIT; }
    unsigned* heads = (unsigned*)(ws + CTL_Q2B + rep * 4096); LAS int* qslot = (LAS int*)(lds + LDS_MISC + LM_QSLOT);
    const int own = (int)(xb_xcc_id() & 7u); int cur = 0;
    for (;;) {
        __syncthreads();
        if (my_tid() == 0) { int item = -1;
            while (cur < 8) { const int qi = (own + cur) & 7; const int per = 64 + (pre[128 * (qi + 1)] - pre[128 * qi]);
                const unsigned i = __hip_atomic_fetch_add(heads + 64 * qi, 1u, __ATOMIC_RELAXED, __HIP_MEMORY_SCOPE_AGENT);
                if (i < (unsigned)per) { item = (qi << 20) | (int)i; break; } ++cur; }
            qslot[0] = item; }
        __syncthreads();
        const int it = __builtin_amdgcn_readfirstlane(qslot[0]); if (it < 0) break;
        int tid_o = my_tid(); asm volatile("" : "+v"(tid_o)); const int tid_i = tid_o; const int wv = tid_i >> 6, lane = tid_i & 63, r32 = lane & 31, hi = lane >> 5;
        LAS float* wsf = (LAS float*)(lds + LDS_MISC + LM_ATTN) + wv * 64;
        const int g = it >> 20, i = it & 0xfffff;
        if (i < 64) {
            const int dbh = 2 * g + (i >> 5), qb = 31 - (i & 31), b = dbh >> 2, h = dbh & 3;
            const bf16_t* Qw = QKV + ((size_t)b * SEQ + qb * 256) * EVEN_IN + 1536 + h * 128; const bf16_t* Kb = QKV + (size_t)b * SEQ * EVEN_IN + 2048 + h * 128; const bf16_t* Vb = QKV + (size_t)b * SEQ * EVEN_IN + 2560 + h * 128;
            LAS unsigned* stash = (LAS unsigned*)(lds + 49152 + wv * 8192);
            f32x16 o[4];
            float mo_, lo_; const bf16_t* qrow = Qw + (size_t)(wv * 32 + r32) * EVEN_IN;
            att::attn_unit_safe<64, 128, 0>(lds, wsf, qrow, Kb, EVEN_IN, nullptr, Vb, EVEN_IN, qb, 0u, o, mo_, lo_);
#pragma unroll
            for (int db = 0; db < 4; ++db)
#pragma unroll
                for (int r = 0; r < 16; r += 2) stash[(db * 8 + (r >> 1)) * 64 + lane] = cvt_pk_bf16(o[db][r], o[db][r + 1]);
            att::attn_unit_safe<64, 128, 0>(lds, wsf, qrow + 64, Kb + 64, EVEN_IN, nullptr, Vb, EVEN_IN, qb, 0u, o, mo_, lo_);
            float ssq[16];
#pragma unroll
            for (int r = 0; r < 16; ++r) ssq[r] = 0.f;
#pragma unroll
            for (int db = 0; db < 4; ++db)
#pragma unroll
                for (int r = 0; r < 16; r += 2) { const unsigned w = stash[(db * 8 + (r >> 1)) * 64 + lane];
                    const float a0 = bf2f((unsigned short)(w & 0xffffu)) - lam * o[db][r], a1 = bf2f((unsigned short)(w >> 16)) - lam * o[db][r + 1];
                    o[db][r] = a0; o[db][r + 1] = a1; ssq[r] += a0 * a0; ssq[r + 1] += a1 * a1; }
            const float* subg = ARG_IN(7);
            float gs[4];
#pragma unroll
            for (int db = 0; db < 4; ++db) gs[db] = subg[db * 32 + r32] * (1.0f - LAM_INIT);
#pragma unroll
            for (int r = 0; r < 16; ++r) { float s = ssq[r];
#pragma unroll
                for (int ofs = 1; ofs < 32; ofs <<= 1) s += __shfl_xor(s, ofs);
                const float rs = 1.0f / sqrtf(s * (1.0f / 128.0f) + NORM_EPS);
#pragma unroll
                for (int db = 0; db < 4; ++db) o[db][r] *= rs * gs[db]; }
            att::store_o<4>(o, OMIX + ((size_t)b * SEQ + qb * 256 + wv * 32) * DM + 512 + h * 128, DM, r32, hi);
        } else {
            const int gc = pre[128 * g] + (i - 64);
            int l = 128 * g; { int lo_ = 128 * g, hi_ = 128 * g + 127;
                while (lo_ < hi_) { const int mid = (lo_ + hi_ + 1) >> 1; if (pre[mid] <= gc) lo_ = mid; else hi_ = mid - 1; } l = __builtin_amdgcn_readfirstlane(lo_); }
            const int ch = gc - pre[l], cnt = lcnt[l], n = (cnt - 256 * ch) < 256 ? (cnt - 256 * ch) : 256;
            const int mbh = l >> 5, jb = l & 31, b = mbh >> 3, h = mbh & 7;
            const int idx = 32 * wv + r32; const bool valid = idx < n;
            const int e = lst[lst_base(l) + 256 * ch + (valid ? idx : 0)];
            const int qpos = e >> 2, sl = e & 3;
            const bf16_t* qrow = QKV + ((size_t)b * SEQ + qpos) * EVEN_IN + h * 64; const bf16_t* Kb = QKV + (size_t)b * SEQ * EVEN_IN + 512 + h * 64; const bf16_t* Vb = QKV + (size_t)b * SEQ * EVEN_IN + 1024 + h * 64;
            f32x16 o[2]; float mo, lo;
            att::attn_unit_safe<64, 64, 3>(lds, wsf, qrow, Kb, EVEN_IN, nullptr, Vb, EVEN_IN, jb, 0u, o, mo, lo);
            LAS int* tab = (LAS int*)wsf;
            if (hi == 0) tab[r32] = valid ? e : -1;
            asm volatile("s_waitcnt lgkmcnt(0)" ::: "memory");
#pragma unroll
            for (int a = 0; a < 4; ++a) { const i32x4 ev = *(LAS const i32x4*)(tab + 8 * a + 4 * hi);
#pragma unroll
                for (int k = 0; k < 4; ++k) { const int ee = (k == 0) ? ev.x : (k == 1) ? ev.y : (k == 2) ? ev.z : ev.w;
                    if (ee >= 0) { const int qq = ee >> 2, ss = ee & 3; bf16_t* dst = (bf16_t*)X + (size_t)ss * NT * 512 + ((size_t)b * SEQ + qq) * 512 + h * 64 + r32;
                        dst[0] = (bf16_t)(cvt_pk_bf16(o[0][4 * a + k], 0.f) & 0xffffu); dst[32] = (bf16_t)(cvt_pk_bf16(o[1][4 * a + k], 0.f) & 0xffffu); } } }
            if (hi == 0 && valid) pml[((size_t)sl * NT + (size_t)b * SEQ + qpos) * 8 + h] = (f32x2){mo, lo};
        }
    }
}
template <int rep> __device__ __forceinline__ void ph_moba_merge(LAS unsigned char* lds, const int G, const int bx) { const int tid = my_tid(); (void)tid; PHASE_ENV();
    const f32x2* pml = (const f32x2*)(ws + WS_PML); const int lane = tid & 63, h = lane >> 3;
    struct Row { f32x2 a3, a[3]; u32x4 v3, v[3]; int np; };
    auto ld = [&](int row, Row& R) { const int qb = (row & (SEQ - 1)) >> 8; R.np = qb < 3 ? qb : 3;
        R.a3 = pml[((size_t)3 * NT + row) * 8 + h]; R.v3 = *(const u32x4*)(OMIX + (size_t)row * DM + lane * 8);
#pragma unroll
        for (int s = 0; s < 3; ++s) if (s < R.np) { R.a[s] = pml[((size_t)s * NT + row) * 8 + h]; R.v[s] = *(const u32x4*)((const bf16_t*)X + (size_t)s * NT * 512 + (size_t)row * 512 + lane * 8); }
                                     else { R.a[s] = (f32x2){-INFINITY, 0.f}; R.v[s] = (u32x4){0u, 0u, 0u, 0u}; } };
    auto fn = [&](int row, const Row& R) { float M = R.a3.x;
#pragma unroll
        for (int s = 0; s < 3; ++s) M = fmaxf(M, R.a[s].x);
        float w3 = R.a3.y * __builtin_amdgcn_exp2f(R.a3.x - M), W = w3; float w[3];
#pragma unroll
        for (int s = 0; s < 3; ++s) { w[s] = (s < R.np) ? R.a[s].y * __builtin_amdgcn_exp2f(R.a[s].x - M) : 0.f; W += w[s]; }
        const float rW = 1.0f / W; float acc[8];
#pragma unroll
        for (int k = 0; k < 4; ++k) { acc[2 * k] = w3 * bf2f((unsigned short)(R.v3[k] & 0xffffu)); acc[2 * k + 1] = w3 * bf2f((unsigned short)(R.v3[k] >> 16)); }
#pragma unroll
        for (int s = 0; s < 3; ++s)
#pragma unroll
            for (int k = 0; k < 4; ++k) { acc[2 * k] += w[s] * bf2f((unsigned short)(R.v[s][k] & 0xffffu)); acc[2 * k + 1] += w[s] * bf2f((unsigned short)(R.v[s][k] >> 16)); }
        bf16_t* op = OMIX + (size_t)row * DM + lane * 8;
        *(u32x4*)(rep ? ((bf16_t*)X + (size_t)3 * NT * 512 + (size_t)row * 512 + lane * 8) : op) = (u32x4){cvt_pk_bf16(acc[0] * rW, acc[1] * rW), cvt_pk_bf16(acc[2] * rW, acc[3] * rW), cvt_pk_bf16(acc[4] * rW, acc[5] * rW), cvt_pk_bf16(acc[6] * rW, acc[7] * rW)}; };
    const int gw = bx * NWAVES + (tid >> 6), ngw = G * NWAVES;
    for (int row = gw; row < NT; row += 2 * ngw) { const int row2 = row + ngw; const bool two = row2 < NT;
        Row A, B; ld(row, A); if (two) ld(row2, B);
        fn(row, A); if (two) fn(row2, B); }
}
template <int rep> __device__ __forceinline__ void ph_wout0(LAS unsigned char* lds, const int G, const int bx) { const int tid = my_tid(); (void)tid; PHASE_ENV();
        pg8::DenseSched S; S.init(OMIX, DM * 2, ws + WS_W_OUT0T, NT, DM, DM, G, bx);
        pg8::EpiWout<false> E{ARG_IN(0), XB};
        pg8::gemm_phase<pg8::EpiWout<false>, pg8::DenseSched, true, true>(lds, DM, S, E);
    }
template <int rep, int L> __device__ __forceinline__ void ph_route(LAS unsigned char* lds, const int G, const int bx) { const int tid = my_tid(); (void)tid; PHASE_ENV(); route_phase(lds, XB, (const bf16_t*)(ws + WS_W_RT) + (size_t)L * 48 * DM, ARG_IN(17) + L * 4, ARG_IN(19) + L * 32, rstd + (L == 0 ? 1 : 3) * NT,
                              (int*)(ws + (L == 0 ? CTL_CNT0 : CTL_CNT1)), (int*)(ws + WS_LIST), (float*)(ws + WS_GW), G, bx); }
template <int rep, int L> __device__ __forceinline__ void ph_moe_up(LAS unsigned char* lds, const int G, const int bx) { const int tid = my_tid(); (void)tid; PHASE_ENV(); moe_tables(lds, (const int*)(ws + (L == 0 ? CTL_CNT0 : CTL_CNT1)));
        MoeSched<true> S; S.A = (const char*)XB; S.Bt = (const char*)(ws + WS_W_UPT) + (size_t)L * NEXP * 512 * DM * 2; S.cnt = (LAS const int*)(lds + LDS_MISC + LM_CNT); S.pbase = (LAS const int*)(lds + LDS_MISC + LM_PBASE);
        S.rowoff = (LAS const unsigned*)(lds + LDS_MISC + LM_ROWOFF); S.lda_b = DM * 2; S.K2 = DM * 2; S.upp = 2; S.G = G; S.c = bx;
        { LAS unsigned* ro = (LAS unsigned*)(lds + LDS_MISC + LM_ROWOFF); const int* list = (const int*)(ws + WS_LIST); pg8::Unit u;
          for (int i = 0; i < 8 && S.next(i, u); ++i) if (tid < 256) { const int pos = u.panel * 256 + tid; ro[i * 256 + tid] = (tid < u.nrows) ? (unsigned)(list[(size_t)u.e * NT + pos] >> 1) * (DM * 2u) : 0u; }
          __syncthreads(); }
        pg8::EpiMoeUp E{(const int*)(ws + WS_LIST), rstd + (L == 0 ? 1 : 3) * NT, (bf16_t*)(ws + WS_H)};
        pg8::gemm_phase<pg8::EpiMoeUp, MoeSched<true>, true, true>(lds, DM, S, E);
        if (rep == 0) { if (L == 0) prep_in_tail<0>(lds, G, bx, S.pbase[32] * 2); else prep_in_tail<2>(lds, G, bx, S.pbase[32] * 2); } }
template <int rep, int L> __device__ __forceinline__ void ph_moe_dn(LAS unsigned char* lds, const int G, const int bx) { const int tid = my_tid(); (void)tid; PHASE_ENV(); moe_tables(lds, (const int*)(ws + (L == 0 ? CTL_CNT0 : CTL_CNT1)));
        MoeSched<false> S; S.A = (const char*)(ws + WS_H); S.Bt = (const char*)(ws + WS_W_DNT) + (size_t)L * NEXP * DM * FF * 2; S.cnt = (LAS const int*)(lds + LDS_MISC + LM_CNT); S.pbase = (LAS const int*)(lds + LDS_MISC + LM_PBASE);
        S.rowoff = (LAS const unsigned*)(lds + LDS_MISC + LM_ROWOFF); S.lda_b = FF * 2; S.K2 = FF * 2; S.upp = 4; S.G = G; S.c = bx;
        pg8::EpiMoeDn E{(const int*)(ws + WS_LIST), (const float*)(ws + WS_GW), (bf16_t*)(ws + WS_Y)};
        pg8::gemm_phase<pg8::EpiMoeDn, MoeSched<false>, true, true>(lds, FF, S, E);
 }
template <int rep> __device__ __forceinline__ void ph_rowpass(LAS unsigned char* lds, const int G, const int bx) { const int tid = my_tid(); (void)tid; PHASE_ENV(); row_phase<true>(XB, (const bf16_t*)(ws + WS_Y), XB, rstd + 2 * NT, nullptr, nullptr, bx * NWAVES + (tid >> 6), G * NWAVES, tid & 63); }
template <int rep> __device__ __forceinline__ void ph_win1(LAS unsigned char* lds, const int G, const int bx) { const int tid = my_tid(); (void)tid; PHASE_ENV();
        pg8::DenseSched S; S.init(XB, DM * 2, ws + WS_W_IN1T, NT, ODD_INP, DM, G, bx);
        pg8::EpiWin1 E{rstd + 2 * NT, (const f32x2*)(ws + WS_CS32), (bf16_t*)(ws + WS_Z1), (bf16_t*)(ws + WS_KR), (LAS float*)(lds + LDS_MISC + LM_STAT)};
        pg8::gemm_phase<pg8::EpiWin1, pg8::DenseSched, true, true>(lds, DM, S, E);
    }
template <int rep> __device__ __forceinline__ void ph_qup(LAS unsigned char* lds, const int G, const int bx) { const int tid = my_tid(); (void)tid; PHASE_ENV();
        pg8::DenseSched S; S.init(ws + WS_Z1, ODD_INP * 2, ws + WS_W_QUPT, NT, 1536, 256, G, bx);
        pg8::EpiQup E{(const f32x2*)(ws + WS_CS32), (bf16_t*)(ws + WS_Q1)};
        pg8::gemm_phase<pg8::EpiQup, pg8::DenseSched, true, true>(lds, 256, S, E);
    }
template <int rep> __device__ __forceinline__ void ph_kvup(LAS unsigned char* lds, const int G, const int bx) { const int tid = my_tid(); (void)tid; PHASE_ENV();
        pg8::DenseSched S; S.init(ws + WS_Z1 + 256 * 2, ODD_INP * 2, ws + WS_W_KVUPT, NT, 2048, 128, G, bx);
        pg8::EpiKvup E{(bf16_t*)(ws + WS_KN1), (bf16_t*)(ws + WS_V1)};
        pg8::gemm_phase<pg8::EpiKvup, pg8::DenseSched, true, true>(lds, 128, S, E);
    }
template <int rep> __device__ __forceinline__ void ph_mla(LAS unsigned char* lds, const int G, const int bx) { const int tid = my_tid(); (void)tid; PHASE_ENV();
        att::Queue q; q.heads = (unsigned*)(ws + CTL_Q10 + rep * 4096); q.per = 256; q.slot = (LAS int*)(lds + LDS_MISC + LM_QSLOT); q.own = (int)(xb_xcc_id() & 7u); q.cur = 0;
        LAS float* wsf = (LAS float*)(lds + LDS_MISC + LM_ATTN) + (tid >> 6) * 64;
        const bf16_t* Q1 = (const bf16_t*)(ws + WS_Q1); const bf16_t* KN1 = (const bf16_t*)(ws + WS_KN1); const bf16_t* KR = (const bf16_t*)(ws + WS_KR); const bf16_t* V1 = (const bf16_t*)(ws + WS_V1);
        for (int it = att::queue_next(q); it >= 0; it = att::queue_next(q)) {
            const int g = it >> 8, i = it & 255, bh = g * 8 + (i >> 5), qb = 31 - (i & 31), b = bh >> 4, h = bh & 15;
            f32x16 o[2];
            float mo_, lo_; att::attn_unit_safe<96, 64, 0>(lds, wsf, Q1 + ((size_t)b * SEQ + qb * 256 + (tid >> 6) * 32 + (tid & 31)) * 1536 + h * 96, KN1 + (size_t)b * SEQ * 1024 + h * 64, 1024, KR + (size_t)b * SEQ * 32, V1 + (size_t)b * SEQ * 1024 + h * 64, 1024, qb, 0u, o, mo_, lo_);
            const int lane = tid & 63;
            att::store_o<2>(o, OMIX + ((size_t)b * SEQ + qb * 256 + (tid >> 6) * 32) * DM + h * 64, DM, lane & 31, lane >> 5);
        }
    }
template <int rep> __device__ __forceinline__ void ph_wout1(LAS unsigned char* lds, const int G, const int bx) { const int tid = my_tid(); (void)tid; PHASE_ENV();
        pg8::DenseSched S; S.init(OMIX, DM * 2, ws + WS_W_OUT1T, NT, DM, DM, G, bx);
        pg8::EpiWout<true> E{nullptr, XB};
        pg8::gemm_phase<pg8::EpiWout<true>, pg8::DenseSched, true, true>(lds, DM, S, E);
    }
template <int rep> __device__ __forceinline__ void ph_final(LAS unsigned char* lds, const int G, const int bx) { const int tid = my_tid(); (void)tid; PHASE_ENV(); row_phase<true>(XB, (const bf16_t*)(ws + WS_Y), nullptr, nullptr, ARG_IN(23), X, bx * NWAVES + (tid >> 6), G * NWAVES, tid & 63); }

#ifndef PROBE_REP
#define PROBE_REP -1
#endif
__global__ void __launch_bounds__(NTHREADS, 2) mega(MArgs args) {
    LAS unsigned char* lds = (LAS unsigned char*)lds_raw;
    const int G = gridDim.x; const int bx = blockIdx.x;
    if (threadIdx.x < 4) ((LAS unsigned*)(lds + LDS_MISC + LM_BAR))[threadIdx.x] = 0u;
    if ((threadIdx.x & 63) == 0) ((LAS int*)(lds + LDS_MISC + LM_WTAB))[hw_wave_slot()] = (int)(threadIdx.x >> 6);
    __syncthreads();
    XcdBarrier bar = xcd_barrier_post((unsigned*)(args.ws + WS_CTL + CTL_BAR), (volatile LAS unsigned*)(lds + LDS_MISC + LM_BAR));
    const int lo = args.ph_lo, hi = args.ph_hi;
#define IN(k) (lo <= (k) && (k) < hi)
#define SEAM(k) do { if (IN(k) && IN((k) + 1)) xcd_barrier(bar); } while (0)
#define RUN(k, CALL0, CALL1) do { if (IN(k)) { CALL0; if (PROBE_REP == (k)) { xcd_barrier(bar); CALL1; } } SEAM(k); } while (0)
    RUN(0, ph_prologue<0>(lds, G, bx), ph_prologue<1>(lds, G, bx));
    RUN(1, ph_win0<0>(lds, G, bx), ph_win0<1>(lds, G, bx));
#ifndef MOBA_SPARSE
#define MOBA_SPARSE 1
#endif
#if MOBA_SPARSE
    if (IN(2)) { ph_moba_own<0>(lds, G, bx); xcd_barrier(bar); if (PROBE_REP == 20) { ph_moba_own<1>(lds, G, bx); xcd_barrier(bar); } ph_attn0b<0>(lds, G, bx); if (PROBE_REP == 21) { xcd_barrier(bar); ph_attn0b<1>(lds, G, bx); } xcd_barrier(bar); if (PROBE_REP == 22) { ph_moba_merge<1>(lds, G, bx); xcd_barrier(bar); } ph_moba_merge<0>(lds, G, bx); }
    SEAM(2);
#endif
    RUN(3, ph_wout0<0>(lds, G, bx), ph_wout0<1>(lds, G, bx));
    RUN(4, (ph_route<0, 0>(lds, G, bx)), (void)0);
    RUN(5, (ph_moe_up<0, 0>(lds, G, bx)), (ph_moe_up<1, 0>(lds, G, bx)));
    RUN(6, (ph_moe_dn<0, 0>(lds, G, bx)), (ph_moe_dn<1, 0>(lds, G, bx)));
    RUN(7, ph_rowpass<0>(lds, G, bx), (void)0);
    RUN(8, ph_win1<0>(lds, G, bx), ph_win1<1>(lds, G, bx));
    if (IN(9)) { ph_qup<0>(lds, G, bx); if (PROBE_REP == 9) { xcd_barrier(bar); ph_qup<1>(lds, G, bx); } }
    if (IN(9)) { ph_kvup<0>(lds, G, bx); if (PROBE_REP == 9) { xcd_barrier(bar); ph_kvup<1>(lds, G, bx); } }
    SEAM(9);
    RUN(10, ph_mla<0>(lds, G, bx), ph_mla<1>(lds, G, bx));
    RUN(11, ph_wout1<0>(lds, G, bx), (void)0);
    RUN(12, (ph_route<0, 1>(lds, G, bx)), (void)0);
    RUN(13, (ph_moe_up<0, 1>(lds, G, bx)), (ph_moe_up<1, 1>(lds, G, bx)));
    RUN(14, (ph_moe_dn<0, 1>(lds, G, bx)), (ph_moe_dn<1, 1>(lds, G, bx)));
    RUN(15, ph_final<0>(lds, G, bx), (void)0);
#undef RUN
#undef IN
#undef SEAM
}

static int g_grid = 0;
extern "C" void kernel_launch(void* const* d_in, const int* in_sizes, int n_in, void* d_out, int out_size, void* d_ws, size_t ws_size, hipStream_t stream) {
    if (n_in != 24 || in_sizes[0] != NT * DM || out_size != NT * DM || ws_size < WS_END) { fprintf(stderr, "kernel_launch: unexpected shapes (n_in %d, ws %zu)\n", n_in, ws_size); return; }
    if (g_grid == 0) {
        int dev = 0, cus = 0;
        if (hipGetDevice(&dev) != hipSuccess || hipDeviceGetAttribute(&cus, hipDeviceAttributeMultiprocessorCount, dev) != hipSuccess) { fprintf(stderr, "device query failed\n"); g_grid = -1; return; }
        if (hipFuncSetAttribute((const void*)mega, hipFuncAttributeMaxDynamicSharedMemorySize, LDS_BYTES) != hipSuccess) { fprintf(stderr, "hipFuncSetAttribute failed\n"); g_grid = -1; return; }
        int per_cu = 0; (void)hipOccupancyMaxActiveBlocksPerMultiprocessor(&per_cu, (const void*)mega, NTHREADS, LDS_BYTES); (void)hipGetLastError();
        g_grid = cus;
    }
    if (g_grid < 0) return;
    (void)hipMemsetAsync((char*)d_ws + WS_CTL, 0, CTL_BYTES, stream);
    MArgs a{}; for (int i = 0; i < 24; ++i) a.in[i] = (const float*)d_in[i];
    a.out = (float*)d_out; a.ws = (unsigned char*)d_ws; a.ph_lo = 0; a.ph_hi = 16;
    hipLaunchKernelGGL(mega, dim3(g_grid), dim3(NTHREADS), LDS_BYTES, stream, a);
}
```
